# Optimizing an MI355X kernel written in HIP

```python
import jax, jax.numpy as jnp
from jax import lax
import numpy as np

D_MODEL = 1024
BATCH = 8
SEQ = 2048
DEPTH = 2
DEC_BATCH = 128
DEC_SEQ = 4
PAST_LEN = 16384
PAGE_SIZE = 128

CONV_WIDTH = 3
W_CONV = D_MODEL
D_SG = D_MODEL
SG_CHUNK = 128
SG_GROUPS = 4
N_MEM = 256
MEM_HEADS = 4
MEM_HEAD_DIM = D_MODEL // MEM_HEADS
D_ATT = MEM_HEADS * MEM_HEAD_DIM
N_BRANCH = 3
D_FF = 2816
D_IN = 3 * W_CONV + 2 * D_SG + D_ATT + N_BRANCH * D_MODEL
EPS = 1e-6

kernel_name = "gated_branch_shortconv_sgu_memattn_convffn_step"


def _rmsnorm(x, g):
    xf = x.astype(jnp.float32)
    y = xf * lax.rsqrt(jnp.mean(xf * xf, axis=-1, keepdims=True) + EPS)
    return (y * g.astype(jnp.float32)).astype(x.dtype)


def _layernorm(x, g):
    xf = x.astype(jnp.float32)
    mu = jnp.mean(xf, axis=-1, keepdims=True)
    xc = xf - mu
    y = xc * lax.rsqrt(jnp.mean(xc * xc, axis=-1, keepdims=True) + EPS)
    return (y * g.astype(jnp.float32)).astype(x.dtype)


def _causal_dwconv3(x, prev, w):
    xp = jnp.concatenate([prev.astype(x.dtype), x], axis=1)
    y = w[0] * xp[:, :-2] + w[1] * xp[:, 1:-1] + w[2] * xp[:, 2:]
    return y, xp[:, -(CONV_WIDTH - 1):]


def _spatial_gate(v, sg_w, sg_b):
    bsz, t, _ = v.shape
    L = min(t, SG_CHUNK)
    n_chunks = t // L
    mask = jnp.tril(jnp.ones((L, L), dtype=bool))
    w = jnp.where(mask[None], sg_w[:, :L, :L], jnp.zeros((), sg_w.dtype))
    vr = v.reshape(bsz, n_chunks, L, SG_GROUPS, D_SG // SG_GROUPS)
    s = jnp.einsum('gts,bcsgd->bctgd', w, vr) + sg_b[:, :L].T[None, None, :, :, None]
    return s.reshape(bsz, t, D_SG)


def _mem_attention(q, mem_k, mem_v):
    bsz, t, _ = q.shape
    qh = q.reshape(bsz, t, MEM_HEADS, MEM_HEAD_DIM)
    s = jnp.einsum('bthd,bmhd->bhtm', qh.astype(jnp.float32), mem_k.astype(jnp.float32))
    p = jax.nn.softmax(s * (MEM_HEAD_DIM ** -0.5), axis=-1).astype(q.dtype)
    o = jnp.einsum('bhtm,bmhd->bthd', p, mem_v.astype(q.dtype))
    return o.reshape(bsz, t, D_ATT)


def _mem_kv(mem, norm_mem_g, w_k, w_v):
    m = _rmsnorm(mem, norm_mem_g)
    bsz = mem.shape[0]
    k = (m @ w_k).reshape(bsz, N_MEM, MEM_HEADS, MEM_HEAD_DIM)
    v = (m @ w_v).reshape(bsz, N_MEM, MEM_HEADS, MEM_HEAD_DIM)
    return k, v


def _layer(x, conv_a_prev, conv_f_prev, mem_k, mem_v, norm_mix_g, w_in, conv_a_w, sg_ln_g,
           sg_w, sg_b, w_o, norm_ffn_g, w_up, conv_f_w, conv_f_b, w_down):
    z = _rmsnorm(x, norm_mix_g)
    p = z @ w_in
    cuts = np.cumsum([W_CONV, W_CONV, W_CONV, D_SG, D_SG, D_ATT]).tolist()
    a_h, a_c, a_b, u, v, q, g = jnp.split(p, cuts, axis=-1)
    conv_out, conv_a_state = _causal_dwconv3(a_c * a_h, conv_a_prev, conv_a_w)
    y_a = a_b * conv_out
    v_n = _layernorm(v, sg_ln_g)
    y_b = u * _spatial_gate(v_n, sg_w, sg_b)
    y_m = _mem_attention(q, mem_k, mem_v)
    g = jax.nn.sigmoid(g.astype(jnp.float32)).astype(x.dtype)
    g_a, g_b, g_m = jnp.split(g, N_BRANCH, axis=-1)
    x = x + (g_a * y_a + g_b * y_b + g_m * y_m) @ w_o
    h = _rmsnorm(x, norm_ffn_g) @ w_up
    hc, conv_f_state = _causal_dwconv3(h, conv_f_prev, conv_f_w)
    hc = hc + conv_f_b
    a, gt = jnp.split(hc, 2, axis=-1)
    x = x + (jax.nn.silu(gt) * a) @ w_down
    return x, conv_a_state, conv_f_state, v_n


def setup_inputs(seed: int = 0) -> dict:
    key = jax.random.key(seed)
    ks = jax.random.split(key, 24)
    f32 = jnp.float32

    def nrm(k, shape, scale=1.0):
        return jax.random.normal(k, shape, f32) * scale

    def gain(k, shape):
        return 1.0 + 0.01 * jax.random.normal(k, shape, f32)

    return {
        "x_prompt": nrm(ks[0], (BATCH, SEQ, D_MODEL)),
        "x_sample": nrm(ks[1], (DEC_BATCH, DEC_SEQ, D_MODEL)),
        "mem_prompt": nrm(ks[2], (BATCH, N_MEM, D_MODEL)),
        "cache_conv_a": nrm(ks[3], (DEPTH, DEC_BATCH, CONV_WIDTH - 1, W_CONV)),
        "cache_conv_ffn": nrm(ks[4], (DEPTH, DEC_BATCH, CONV_WIDTH - 1, 2 * D_FF)),
        "cache_mem_k": nrm(ks[5], (DEPTH, DEC_BATCH, N_MEM, MEM_HEADS, MEM_HEAD_DIM)),
        "cache_mem_v": nrm(ks[6], (DEPTH, DEC_BATCH, N_MEM, MEM_HEADS, MEM_HEAD_DIM)),
        "norm_mix_g": gain(ks[7], (DEPTH, D_MODEL)),
        "w_in": nrm(ks[8], (DEPTH, D_MODEL, D_IN), D_MODEL ** -0.5),
        "conv_a_w": nrm(ks[9], (DEPTH, CONV_WIDTH, W_CONV), CONV_WIDTH ** -0.5),
        "sg_ln_g": gain(ks[10], (DEPTH, D_SG)),
        "sg_w": nrm(ks[11], (DEPTH, SG_GROUPS, SG_CHUNK, SG_CHUNK), SG_CHUNK ** -0.5),
        "sg_b": gain(ks[12], (DEPTH, SG_GROUPS, SG_CHUNK)),
        "norm_mem_g": gain(ks[13], (DEPTH, D_MODEL)),
        "w_k": nrm(ks[14], (DEPTH, D_MODEL, D_ATT), D_MODEL ** -0.5),
        "w_v": nrm(ks[15], (DEPTH, D_MODEL, D_ATT), D_MODEL ** -0.5),
        "w_o": nrm(ks[16], (DEPTH, D_MODEL, D_MODEL), D_MODEL ** -0.5),
        "norm_ffn_g": gain(ks[17], (DEPTH, D_MODEL)),
        "w_up": nrm(ks[18], (DEPTH, D_MODEL, 2 * D_FF), D_MODEL ** -0.5),
        "conv_f_w": nrm(ks[19], (DEPTH, CONV_WIDTH, 2 * D_FF), CONV_WIDTH ** -0.5),
        "conv_f_b": nrm(ks[20], (DEPTH, 2 * D_FF), 0.01),
        "w_down": nrm(ks[21], (DEPTH, D_FF, D_MODEL), D_FF ** -0.5),
        "norm_final_g": gain(ks[22], (D_MODEL,)),
    }


def reference(x_prompt, x_sample, mem_prompt, cache_conv_a, cache_conv_ffn, cache_mem_k,
              cache_mem_v, norm_mix_g, w_in, conv_a_w, sg_ln_g, sg_w, sg_b, norm_mem_g, w_k,
              w_v, w_o, norm_ffn_g, w_up, conv_f_w, conv_f_b, w_down, norm_final_g):
    xp, xs = x_prompt, x_sample
    bp = x_prompt.shape[0]
    pa_list, pf_list, pk_list, pv_list = [], [], [], []
    sa_list, sf_list, sv_list = [], [], []
    for l in range(DEPTH):
        shared = (norm_mix_g[l], w_in[l], conv_a_w[l], sg_ln_g[l], sg_w[l], sg_b[l], w_o[l],
                  norm_ffn_g[l], w_up[l], conv_f_w[l], conv_f_b[l], w_down[l])
        mk, mv = _mem_kv(mem_prompt, norm_mem_g[l], w_k[l], w_v[l])
        zero_a = jnp.zeros((bp, CONV_WIDTH - 1, W_CONV), xp.dtype)
        zero_f = jnp.zeros((bp, CONV_WIDTH - 1, 2 * D_FF), xp.dtype)
        xp, pa, pf, _ = _layer(xp, zero_a, zero_f, mk, mv, *shared)
        pa_list.append(pa)
        pf_list.append(pf)
        pk_list.append(mk)
        pv_list.append(mv)
        xs, sa, sf, sv = _layer(xs, cache_conv_a[l], cache_conv_ffn[l], cache_mem_k[l],
                                cache_mem_v[l], *shared)
        sa_list.append(sa)
        sf_list.append(sf)
        sv_list.append(sv)
    y_prompt = _rmsnorm(xp, norm_final_g)
    y_sample = _rmsnorm(xs, norm_final_g)
    return (y_prompt, y_sample,
            jnp.stack(pa_list), jnp.stack(pf_list), jnp.stack(pk_list), jnp.stack(pv_list),
            jnp.stack(sa_list), jnp.stack(sf_list), jnp.stack(sv_list))
```

```cpp
#include <hip/hip_runtime.h>
#include <hip/hip_cooperative_groups.h>
#include <cstdio>
namespace cg = cooperative_groups;

#define LAS __attribute__((address_space(3)))
typedef unsigned short bf16_t;
typedef short bf16x8 __attribute__((ext_vector_type(8)));
typedef float f32x4 __attribute__((ext_vector_type(4)));
typedef unsigned u32x4 __attribute__((ext_vector_type(4)));
typedef unsigned u32x2 __attribute__((ext_vector_type(2)));

constexpr int D = 1024, MP = 16384, MS = 512, MT = MP + MS, MMEM = 2048, DIN = 9216, DFF = 2816, DFF2 = 5632;
constexpr int NSEQ = 128;
constexpr size_t O_YP = 0, O_CAP = 17301504, O_CFP = 17334272, O_MK = 17514496, O_MV = 21708800, O_CAS = 25903104, O_CFS = 26427392, O_SV = 29310976;
constexpr size_t WL_IN = 0, WL_KV = (size_t)DIN * D, WL_O = WL_KV + (size_t)2048 * D, WL_UP = WL_O + (size_t)D * D, WL_DN = WL_UP + (size_t)DFF2 * D, WL_SZ = WL_DN + (size_t)D * DFF;
constexpr size_t WS_WT = 0;
constexpr size_t WS_ZA = WS_WT + 2 * WL_SZ * 2;
constexpr size_t WS_Y = WS_ZA + (size_t)(MT + MMEM) * D * 2;
constexpr size_t WS_X = WS_Y + (size_t)MT * D * 2;
constexpr size_t WS_KB = WS_X + (size_t)MT * D * 4;
constexpr size_t WS_VT = WS_KB + (size_t)MMEM * D * 2;
constexpr size_t WS_P = WS_VT + (size_t)MMEM * D * 2;
constexpr size_t WS_H = WS_P;
constexpr size_t WS_F = WS_H + (size_t)MT * DFF2 * 2;
constexpr size_t WS_ST = WS_P + (size_t)MT * DIN * 2;
constexpr size_t WS_BAR = WS_ST + (size_t)2 * MT * 16 * 2 * 4;
constexpr size_t WS_HB = WS_BAR + 16384;
constexpr size_t WS_END = WS_HB + (size_t)256 * 4 * DFF2 * 4;
constexpr int LDS_BYTES = 160 * 1024;
#ifndef DUP_MASK
#define DUP_MASK 0
#endif

struct Params {
    const float *x_prompt, *x_sample, *mem_prompt, *cache_conv_a, *cache_conv_ffn, *cache_mem_k, *cache_mem_v, *norm_mix_g, *w_in, *conv_a_w, *sg_ln_g, *sg_w, *sg_b,
        *norm_mem_g, *w_k, *w_v, *w_o, *norm_ffn_g, *w_up, *conv_f_w, *conv_f_b, *w_down, *norm_final_g;
    float* out; unsigned char* ws;
};

__device__ __forceinline__ unsigned cvt_pk_bf16(float lo, float hi) { unsigned r; asm("v_cvt_pk_bf16_f32 %0, %1, %2" : "=v"(r) : "v"(lo), "v"(hi)); return r; }
__device__ __forceinline__ float bf_lo(unsigned u) { return __uint_as_float(u << 16); }
__device__ __forceinline__ float bf_hi(unsigned u) { return __uint_as_float(u & 0xffff0000u); }
__device__ __forceinline__ float bf2f(bf16_t b) { return __uint_as_float(((unsigned)b) << 16); }
__device__ __forceinline__ bf16_t f2bf(float f) { return (bf16_t)(cvt_pk_bf16(f, 0.f) & 0xffffu); }
__device__ __forceinline__ f32x4 unpack4(u32x2 u) { return (f32x4){bf_lo(u.x), bf_hi(u.x), bf_lo(u.y), bf_hi(u.y)}; }
__device__ __forceinline__ u32x2 pack4(f32x4 v) { u32x2 r; r.x = cvt_pk_bf16(v[0], v[1]); r.y = cvt_pk_bf16(v[2], v[3]); return r; }
__device__ __forceinline__ bf16x8 pack8(f32x4 a, f32x4 b) { u32x4 w; w.x = cvt_pk_bf16(a[0], a[1]); w.y = cvt_pk_bf16(a[2], a[3]); w.z = cvt_pk_bf16(b[0], b[1]); w.w = cvt_pk_bf16(b[2], b[3]); return __builtin_bit_cast(bf16x8, w); }
__device__ __forceinline__ float sigm(float x) { return __builtin_amdgcn_rcpf(1.f + __expf(-x)); }
__device__ __forceinline__ float wave_sum(float v) {
#pragma unroll
    for (int o = 1; o < 64; o <<= 1) v += __shfl_xor(v, o);
    return v;
}
__device__ __forceinline__ float wave_max(float v) {
#pragma unroll
    for (int o = 1; o < 64; o <<= 1) v = fmaxf(v, __shfl_xor(v, o));
    return v;
}
__device__ __forceinline__ void lds_wait() { asm volatile("s_waitcnt lgkmcnt(0)" ::: "memory"); }

constexpr int BM = 256, BK = 64, HALF = 128, HTB = HALF * BK * 2, NXCD = 8, WGM = 4;
__device__ __forceinline__ int lds_byte(int r, int c) { const int st = (r >> 4) * 2 + (c >> 5), rr = r & 15, cc = c & 31, ob = rr * 64 + cc * 2; return st * 1024 + (ob ^ (((ob >> 9) & 1) << 5)); }
__device__ __forceinline__ void stage_rc(int b, int& R, int& C) { const int st = b / 1024, sb = b % 1024, swz = sb ^ (((sb >> 9) & 1) << 5); R = (st >> 1) * 16 + swz / 64; C = (st & 1) * 32 + (swz % 64) / 2; }
__device__ __forceinline__ int perm32(int rho) { const int n = rho >> 4, i = rho & 15; return 8 * (i >> 2) + 4 * n + (i & 3); }
struct Unit { int pm, pn; };
struct Gemm { const bf16_t* A; const bf16_t* Bt; int K; };
struct Sched {
    int nM, nN, nwg, extra, xpm0, xpn0, G, c;
    __device__ __forceinline__ bool next(int i, Unit& u) const {
        const int L = i * G + c;
        if (L >= nwg + extra) return false;
        if (L >= nwg) { const int q = L - nwg; u.pm = xpm0 + (q >> 3); u.pn = xpn0 + (q & 7); return true; }
        int wgid = L; { const int q = nwg / NXCD, r = nwg % NXCD, xcd = wgid % NXCD, off = wgid / NXCD; wgid = (xcd < r ? xcd * (q + 1) : r * (q + 1) + (xcd - r) * q) + off; }
        const int nig = WGM * nN, gid = wgid / nig, fm = gid * WGM, gsz = (nM - fm) < WGM ? (nM - fm) : WGM;
        u.pm = fm + ((wgid % nig) % gsz); u.pn = (wgid % nig) / gsz; return true;
    }
};

template <class Epi>
__device__ __forceinline__ void gemm_phase(LAS unsigned char* lds, const int tid, const Gemm g, const Sched& S, const Epi& E) {
    const int wid = __builtin_amdgcn_readfirstlane(tid >> 6), lane = tid & 63, wr = wid >> 2, wc = wid & 3, fr = lane & 15, fq = lane >> 4;
    const int K = g.K, nt = K / BK;
    unsigned voffA[2], voffB[2];
#pragma unroll
    for (int i = 0; i < 2; ++i) { int R, C; stage_rc(tid * 16 + i * 8192, R, C); const int Rb = Epi::PERM ? ((R & ~31) + perm32(R & 31)) : R;
        voffA[i] = (unsigned)(R * K + C) * 2u; voffB[i] = (unsigned)(Rb * K + C) * 2u; }
    const size_t kstep = (size_t)(BK * 2);
    const size_t hstep = (size_t)HALF * K * 2;
    const size_t tstep = 2 * hstep;
    const unsigned ldsw = (unsigned)wid * 1024u;
    const int aoff = lds_byte(wr * 64 + fr, fq * 8), boff = lds_byte(wc * 32 + fr, fq * 8);
#define PG8_SA(b, h) (((b) * 2 + (h)) * HTB)
#define PG8_SB(b, h) ((4 + (b) * 2 + (h)) * HTB)
#define PG8_STAGE(bufoff, gbase, voff) do { _Pragma("unroll") for (int _i = 0; _i < 2; ++_i) \
        __builtin_amdgcn_global_load_lds((const unsigned*)((const char*)(gbase) + (voff)[_i]), (LAS unsigned*)(lds + (bufoff) + ldsw + _i * 8192), 16, 0, 0); } while (0)
#define PG8_LDA(dst, b, h) do { _Pragma("unroll") for (int m = 0; m < 4; ++m) _Pragma("unroll") for (int k = 0; k < 2; ++k) dst[m][k] = *(const LAS bf16x8*)(lds + PG8_SA(b, h) + aoff + m * 2048 + k * 1024); } while (0)
#define PG8_LDB(dst, b, h) do { _Pragma("unroll") for (int n = 0; n < 2; ++n) _Pragma("unroll") for (int k = 0; k < 2; ++k) dst[n][k] = *(const LAS bf16x8*)(lds + PG8_SB(b, h) + boff + n * 2048 + k * 1024); } while (0)
#define PG8_MMA(ai, bj, At, Bt) do { __builtin_amdgcn_s_setprio(1); _Pragma("unroll") for (int m = 0; m < 4; ++m) _Pragma("unroll") for (int n = 0; n < 2; ++n) _Pragma("unroll") for (int k = 0; k < 2; ++k) \
        acc[ai][bj][m][n] = __builtin_amdgcn_mfma_f32_16x16x32_bf16(Bt[n][k], At[m][k], acc[ai][bj][m][n], 0, 0, 0); __builtin_amdgcn_s_setprio(0); } while (0)
#define PG8_WAIT_V(n) asm volatile("s_waitcnt vmcnt(" #n ")" ::: "memory")
#define PG8_WAIT_L(n) asm volatile("s_waitcnt lgkmcnt(" #n ")" ::: "memory")
#define PG8_BAR __builtin_amdgcn_s_barrier()
#define PG8_SCHED __builtin_amdgcn_sched_barrier(0)
    Unit cur, nxt; int ui = 0;
    if (!S.next(0, cur)) return;
    f32x4 acc[2][2][4][2];
#pragma unroll
    for (int a = 0; a < 2; ++a)
#pragma unroll
        for (int b = 0; b < 2; ++b)
#pragma unroll
            for (int m = 0; m < 4; ++m)
#pragma unroll
                for (int n = 0; n < 2; ++n) acc[a][b][m][n] = (f32x4){0.f, 0.f, 0.f, 0.f};
    bf16x8 At[4][2], B0[2][2], B1[2][2];
    const char* cA = (const char*)g.A + (size_t)cur.pm * tstep; const char* cB = (const char*)g.Bt + (size_t)cur.pn * tstep;
    PG8_STAGE(PG8_SB(0, 0), cB, voffB); PG8_STAGE(PG8_SA(0, 0), cA, voffA); PG8_STAGE(PG8_SB(0, 1), cB + hstep, voffB); PG8_STAGE(PG8_SA(0, 1), cA + hstep, voffA);
    if (wr == 1) PG8_BAR;
    PG8_WAIT_V(4); PG8_BAR;
    PG8_STAGE(PG8_SB(1, 0), cB + kstep, voffB); PG8_STAGE(PG8_SA(1, 0), cA + kstep, voffA); PG8_STAGE(PG8_SB(1, 1), cB + hstep + kstep, voffB);
    PG8_WAIT_V(6); PG8_BAR;
    for (;;) {
        const bool has_next = S.next(ui + 1, nxt);
        const char* nA = has_next ? (const char*)g.A + (size_t)nxt.pm * tstep : cA; const char* nB = has_next ? (const char*)g.Bt + (size_t)nxt.pn * tstep : cB;
        for (int t = 0; t < nt; t += 2) {
            const bool last = (t == nt - 2);
            const char* a1 = cA + (size_t)(t + 1) * kstep;
            const char* a2 = last ? nA : cA + (size_t)(t + 2) * kstep; const char* b2 = last ? nB : cB + (size_t)(t + 2) * kstep;
            const char* a3 = a2 + kstep; const char* b3 = b2 + kstep;
            PG8_LDB(B0, 0, 0); PG8_SCHED; PG8_LDA(At, 0, 0); PG8_STAGE(PG8_SA(1, 1), a1 + hstep, voffA);
            PG8_WAIT_L(8); PG8_BAR; PG8_WAIT_L(0); PG8_MMA(0, 0, At, B0); PG8_BAR; PG8_SCHED;
            PG8_LDB(B1, 0, 1); PG8_STAGE(PG8_SB(0, 0), b2, voffB);
            PG8_BAR; PG8_WAIT_L(0); PG8_MMA(0, 1, At, B1); PG8_BAR;
            PG8_LDA(At, 0, 1); PG8_STAGE(PG8_SA(0, 0), a2, voffA);
            PG8_BAR; PG8_WAIT_L(0); PG8_MMA(1, 0, At, B0); PG8_BAR; PG8_SCHED;
            PG8_STAGE(PG8_SB(0, 1), b2 + hstep, voffB);
            PG8_WAIT_V(6); PG8_BAR; PG8_MMA(1, 1, At, B1); PG8_BAR;
            PG8_LDB(B0, 1, 0); PG8_SCHED; PG8_LDA(At, 1, 0); PG8_STAGE(PG8_SA(0, 1), a2 + hstep, voffA);
            PG8_WAIT_L(8); PG8_BAR; PG8_WAIT_L(0); PG8_MMA(0, 0, At, B0); PG8_BAR; PG8_SCHED;
            PG8_LDB(B1, 1, 1); PG8_STAGE(PG8_SB(1, 0), b3, voffB);
            PG8_BAR; PG8_WAIT_L(0); PG8_MMA(0, 1, At, B1); PG8_BAR;
            PG8_LDA(At, 1, 1); PG8_STAGE(PG8_SA(1, 0), a3, voffA);
            PG8_BAR; PG8_WAIT_L(0); PG8_MMA(1, 0, At, B0); PG8_BAR; PG8_SCHED;
            PG8_STAGE(PG8_SB(1, 1), b3 + hstep, voffB);
            PG8_WAIT_V(6); PG8_BAR; PG8_MMA(1, 1, At, B1); PG8_BAR;
        }
        E(acc, cur, wr, wc, fr, fq);
        if (!has_next) break;
#pragma unroll
        for (int a = 0; a < 2; ++a)
#pragma unroll
            for (int b = 0; b < 2; ++b)
#pragma unroll
                for (int m = 0; m < 4; ++m)
#pragma unroll
                    for (int n = 0; n < 2; ++n) acc[a][b][m][n] = (f32x4){0.f, 0.f, 0.f, 0.f};
        cur = nxt; cA = nA; cB = nB; ++ui;
    }
    PG8_WAIT_V(0);
    if (wr == 0) PG8_BAR;
    PG8_BAR;
#undef PG8_SA
#undef PG8_SB
#undef PG8_STAGE
#undef PG8_LDA
#undef PG8_LDB
#undef PG8_MMA
#undef PG8_WAIT_V
#undef PG8_WAIT_L
#undef PG8_BAR
#undef PG8_SCHED
}

__device__ __forceinline__ float silu_mul(float gt, float a) { return gt * a * __builtin_amdgcn_rcpf(1.f + __expf(-gt)); }
__device__ __forceinline__ float dpp_prev1(float prev, float cur) {
    const int o = __builtin_amdgcn_update_dpp(0, __builtin_bit_cast(int, prev), 0x10F, 0xf, 0xf, true);
    return __builtin_bit_cast(float, __builtin_amdgcn_update_dpp(o, __builtin_bit_cast(int, cur), 0x111, 0xf, 0xf, false)); }
__device__ __forceinline__ float dpp_prev2(float prev, float cur) {
    const int o = __builtin_amdgcn_update_dpp(0, __builtin_bit_cast(int, prev), 0x10E, 0xf, 0xf, true);
    return __builtin_bit_cast(float, __builtin_amdgcn_update_dpp(o, __builtin_bit_cast(int, cur), 0x112, 0xf, 0xf, false)); }
__device__ __forceinline__ size_t p_off(int row, int seg, int g) { return ((((size_t)(row >> 7) * 9 + seg) * 4 + g) * 128 + (row & 127)) * 256; }
struct EpiB {
    static constexpr bool PERM = true;
    int mode, l; bf16_t* O; int ldc; bf16_t* KB; bf16_t* VT; float* out; float* ST; bf16_t* Fo; float* HB; const float* cw; const float* cb;
    __device__ __forceinline__ void operator()(const f32x4 (&acc)[2][2][4][2], const Unit& u, int wr, int wc, int fr, int fq) const {
        const int row0 = u.pm * BM + wr * 64 + fr, col0 = u.pn * BM + wc * 32 + 8 * fq;
        if (mode == 0 && u.pm >= MT / BM) {
            const int rr0 = row0 - MT, cc0 = col0 - DIN;
            if (cc0 < 1024) {
                float* ko = out + O_MK + (size_t)l * (MMEM * D);
#pragma unroll
                for (int ai = 0; ai < 2; ++ai)
#pragma unroll
                    for (int m = 0; m < 4; ++m) { const int rr = rr0 + ai * HALF + m * 16;
#pragma unroll
                        for (int bj = 0; bj < 2; ++bj) { const f32x4 v0 = acc[ai][bj][m][0], v1 = acc[ai][bj][m][1]; const size_t o = (size_t)rr * D + cc0 + bj * HALF;
                            *(f32x4*)(ko + o) = v0; *(f32x4*)(ko + o + 4) = v1;
                            u32x4 w; w.x = cvt_pk_bf16(v0[0], v0[1]); w.y = cvt_pk_bf16(v0[2], v0[3]); w.z = cvt_pk_bf16(v1[0], v1[1]); w.w = cvt_pk_bf16(v1[2], v1[3]);
                            *(u32x4*)(KB + o) = w; } }
            } else {
                float* vo = out + O_MV + (size_t)l * (MMEM * D);
#pragma unroll
                for (int ai = 0; ai < 2; ++ai)
#pragma unroll
                    for (int m = 0; m < 4; ++m) { const int rr = rr0 + ai * HALF + m * 16; const int b = rr >> 8, mm = rr & 255;
#pragma unroll
                        for (int bj = 0; bj < 2; ++bj) { const f32x4 v0 = acc[ai][bj][m][0], v1 = acc[ai][bj][m][1]; const int c2 = cc0 - 1024 + bj * HALF;
                            const size_t o = (size_t)rr * D + c2;
                            *(f32x4*)(vo + o) = v0; *(f32x4*)(vo + o + 4) = v1;
                            bf16_t* vt = VT + ((size_t)(b * 4) * 256 + c2) * 256 + mm;
#pragma unroll
                            for (int j = 0; j < 4; ++j) { vt[(size_t)j * 256] = f2bf(v0[j]); vt[(size_t)(4 + j) * 256] = f2bf(v1[j]); } } }
            }
            return;
        }
        if (mode == 0 && u.pn >= 16 && u.pn < 20) {
#pragma unroll
            for (int ai = 0; ai < 2; ++ai)
#pragma unroll
                for (int m = 0; m < 4; ++m) { const f32x4 a0 = acc[ai][0][m][0], a1 = acc[ai][0][m][1], a2 = acc[ai][1][m][0], a3 = acc[ai][1][m][1];
                    const f32x4 sv = (a0 + a1) + (a2 + a3), qv = (a0 * a0 + a1 * a1) + (a2 * a2 + a3 * a3);
                    float ss = (sv[0] + sv[1]) + (sv[2] + sv[3]), qq = (qv[0] + qv[1]) + (qv[2] + qv[3]);
                    ss += __shfl_xor(ss, 16); qq += __shfl_xor(qq, 16); ss += __shfl_xor(ss, 32); qq += __shfl_xor(qq, 32);
                    if (fq == 0) { float* sp = ST + (((size_t)l * MT + row0 + ai * HALF + m * 16) * 16 + (u.pn - 16) * 4 + wc) * 2; sp[0] = ss; sp[1] = qq; } }
        }
        if (mode == 1) {
            const int ca = u.pn * 128 + wc * 32 + 8 * fq;
            if (u.pm >= MP / BM) {
#pragma unroll
                for (int ai = 0; ai < 2; ++ai)
#pragma unroll
                    for (int m = 0; m < 4; ++m) { const int row = row0 + ai * HALF + m * 16; const int q = row - MP, t = q & 3;
#pragma unroll
                        for (int bj = 0; bj < 2; ++bj) { const f32x4 v0 = acc[ai][bj][m][0], v1 = acc[ai][bj][m][1];
                            u32x4 w; w.x = cvt_pk_bf16(v0[0], v0[1]); w.y = cvt_pk_bf16(v0[2], v0[3]); w.z = cvt_pk_bf16(v1[0], v1[1]); w.w = cvt_pk_bf16(v1[2], v1[3]);
                            *(u32x4*)(O + (size_t)row * DFF2 + bj * DFF + ca) = w;
                            if (t >= 2) { float* dst = out + O_CFS + ((size_t)(l * NSEQ + (q >> 2)) * 2 + (t - 2)) * DFF2 + bj * DFF + ca; *(f32x4*)dst = v0; *(f32x4*)(dst + 4) = v1; } } }
                return;
            }
#pragma unroll
            for (int n = 0; n < 2; ++n) {
                const int cn = ca + 4 * n;
                const f32x4 wa0 = *(const f32x4*)(cw + cn), wa1 = *(const f32x4*)(cw + DFF2 + cn), wa2 = *(const f32x4*)(cw + 2 * DFF2 + cn), ba = *(const f32x4*)(cb + cn);
                const f32x4 wg0 = *(const f32x4*)(cw + DFF + cn), wg1 = *(const f32x4*)(cw + DFF2 + DFF + cn), wg2 = *(const f32x4*)(cw + 2 * DFF2 + DFF + cn), bg = *(const f32x4*)(cb + DFF + cn);
#pragma unroll
                for (int ai = 0; ai < 2; ++ai) {
                    const int grow = u.pm * BM + ai * HALF + wr * 64, gi = grow >> 6;
#pragma unroll
                    for (int m = 0; m < 4; ++m) {
                        const int row = grow + 16 * m + fr;
                        const f32x4 ca4 = acc[ai][0][m][n], cg4 = acc[ai][1][m][n], pa4 = acc[ai][0][m > 0 ? m - 1 : 0][n], pg4 = acc[ai][1][m > 0 ? m - 1 : 0][n];
                        f32x4 x1a, x2a, x1g, x2g;
#pragma unroll
                        for (int j = 0; j < 4; ++j) { x1a[j] = dpp_prev1(pa4[j], ca4[j]); x2a[j] = dpp_prev2(pa4[j], ca4[j]); x1g[j] = dpp_prev1(pg4[j], cg4[j]); x2g[j] = dpp_prev2(pg4[j], cg4[j]); }
                        const f32x4 fa = wa0 * x2a + wa1 * x1a + wa2 * ca4 + ba, fg = wg0 * x2g + wg1 * x1g + wg2 * cg4 + bg;
                        if (m > 0 || fr >= 2) { u32x2 w; w.x = cvt_pk_bf16(silu_mul(fg[0], fa[0]), silu_mul(fg[1], fa[1])); w.y = cvt_pk_bf16(silu_mul(fg[2], fa[2]), silu_mul(fg[3], fa[3]));
                            *(u32x2*)(Fo + (size_t)row * DFF + cn) = w; }
                        if ((m == 0 && fr < 2) || (m == 3 && fr >= 14)) {
                            float* hb = HB + ((size_t)gi * 4 + (m == 0 ? fr : fr - 12)) * DFF2 + cn;
                            *(f32x4*)hb = ca4; *(f32x4*)(hb + DFF) = cg4;
                            const int t = row & 2047;
                            if (t >= 2046) { float* dst = out + O_CFP + ((size_t)(l * 8 + (row >> 11)) * 2 + (t - 2046)) * DFF2 + cn; *(f32x4*)dst = ca4; *(f32x4*)(dst + DFF) = cg4; }
                        }
                    }
                }
            }
            return;
        }
#pragma unroll
        for (int ai = 0; ai < 2; ++ai)
#pragma unroll
            for (int m = 0; m < 4; ++m) { const int row = row0 + ai * HALF + m * 16; bf16_t* rowp = O + p_off(row, u.pn >> 2, u.pn & 3) + wc * 32 + 8 * fq;
#pragma unroll
                for (int bj = 0; bj < 2; ++bj) { const f32x4 v0 = acc[ai][bj][m][0], v1 = acc[ai][bj][m][1];
                    u32x4 w; w.x = cvt_pk_bf16(v0[0], v0[1]); w.y = cvt_pk_bf16(v0[2], v0[3]); w.z = cvt_pk_bf16(v1[0], v1[1]); w.w = cvt_pk_bf16(v1[2], v1[3]);
                    *(u32x4*)(rowp + bj * HALF) = w; } }
    }
};
struct EpiRes {
    static constexpr bool PERM = false;
    const float* src_p; const float* src_s; float* dst;
    __device__ __forceinline__ void operator()(const f32x4 (&acc)[2][2][4][2], const Unit& u, int wr, int wc, int fr, int fq) const {
        const int row0 = u.pm * BM + wr * 64 + fr, col0 = u.pn * BM + wc * 32 + 4 * fq;
        const float* sb = (u.pm < MP / BM) ? src_p : (src_s - (size_t)MP * D);
#pragma unroll
        for (int ai = 0; ai < 2; ++ai) {
            f32x4 rv[4][2][2];
#pragma unroll
            for (int m = 0; m < 4; ++m)
#pragma unroll
                for (int bj = 0; bj < 2; ++bj)
#pragma unroll
                    for (int n = 0; n < 2; ++n) rv[m][bj][n] = *(const f32x4*)(sb + (size_t)(row0 + ai * HALF + m * 16) * D + col0 + bj * HALF + n * 16);
            __builtin_amdgcn_sched_barrier(0);
#pragma unroll
            for (int m = 0; m < 4; ++m)
#pragma unroll
                for (int bj = 0; bj < 2; ++bj)
#pragma unroll
                    for (int n = 0; n < 2; ++n) *(f32x4*)(dst + (size_t)(row0 + ai * HALF + m * 16) * D + col0 + bj * HALF + n * 16) = rv[m][bj][n] + acc[ai][bj][m][n];
            __builtin_amdgcn_sched_barrier(0);
        }
    }
};

__device__ __forceinline__ void small_gemm_res(const bf16_t* A, const bf16_t* Bt, int K, const float* src, float* dst, int c, int tid, LAS unsigned char* lds) {
    const int w = __builtin_amdgcn_readfirstlane(tid >> 6), lane = tid & 63, fr = lane & 15, fq = lane >> 4;
    const int cg = w & 3, kh = w >> 2;
    const int row0 = 16 * (c & 31), col0 = 128 * (c >> 5) + 32 * cg, Kh = K >> 1;
    const bf16_t* ap = A + (size_t)(row0 + fr) * K + kh * Kh + 8 * fq;
    const bf16_t* bp = Bt + (size_t)(col0 + fr) * K + kh * Kh + 8 * fq;
    const size_t b16 = (size_t)16 * K;
    f32x4 acc0 = {0.f, 0.f, 0.f, 0.f}, acc1 = acc0;
    struct T { bf16x8 a[4], b0[4], b1[4]; };
    auto ldt = [&](int k) -> T { T t;
#pragma unroll
        for (int i = 0; i < 4; ++i) { t.a[i] = *(const bf16x8*)(ap + k + 32 * i); t.b0[i] = *(const bf16x8*)(bp + k + 32 * i); t.b1[i] = *(const bf16x8*)(bp + b16 + k + 32 * i); }
        return t; };
    auto mma = [&](const T& t) {
#pragma unroll
        for (int i = 0; i < 4; ++i) { acc0 = __builtin_amdgcn_mfma_f32_16x16x32_bf16(t.b0[i], t.a[i], acc0, 0, 0, 0); acc1 = __builtin_amdgcn_mfma_f32_16x16x32_bf16(t.b1[i], t.a[i], acc1, 0, 0, 0); } };
    T t0 = ldt(0);
#pragma unroll 1
    for (int k = 0; k < Kh; k += 256) {
        const bool h1 = k + 128 < Kh, h2 = k + 256 < Kh;
        T t1 = t0;
        if (h1) t1 = ldt(k + 128);
        mma(t0);
        if (h2) t0 = ldt(k + 256);
        if (h1) mma(t1);
    }
    LAS f32x4* ex = (LAS f32x4*)lds + (cg * 64 + lane) * 2;
    if (kh == 1) { ex[0] = acc0; ex[1] = acc1; }
    __syncthreads();
    if (kh == 0) {
        acc0 += ex[0]; acc1 += ex[1];
        const size_t o = (size_t)(row0 + fr) * D + col0 + 4 * fq;
        *(f32x4*)(dst + o) = *(const f32x4*)(src + o) + acc0;
        *(f32x4*)(dst + o + 16) = *(const f32x4*)(src + o + 16) + acc1;
    }
    __syncthreads();
}

__device__ __forceinline__ void transpose_item(const float* W, int K, int N, bf16_t* WT, LAS float* scr, int item, int lane, bool ffn_perm = false) {
    const int nblk = N / 32, kb = item / nblk, nb = item % nblk, k0 = 64 * kb, n0 = 32 * nb;
    const int d0 = !ffn_perm ? n0 : (n0 < DFF ? (n0 >> 7) * 256 + (n0 & 127) : ((n0 - DFF) >> 7) * 256 + 128 + ((n0 - DFF) & 127));
    {
        const int kr = lane >> 3, n4 = lane & 7;
        f32x4 v[8];
#pragma unroll
        for (int i = 0; i < 8; ++i) v[i] = __builtin_nontemporal_load((const f32x4*)(W + (size_t)(k0 + 8 * i + kr) * N + n0 + 4 * n4));
#pragma unroll
        for (int i = 0; i < 8; ++i) { LAS float* d = scr + (8 * i + kr) * 33 + 4 * n4; d[0] = v[i][0]; d[1] = v[i][1]; d[2] = v[i][2]; d[3] = v[i][3]; }
    }
    lds_wait();
    const int c = lane & 7;
#pragma unroll
    for (int j = 0; j < 4; ++j) { const int n = (lane >> 3) + 8 * j; const LAS float* s = scr + (8 * c) * 33 + n;
        u32x4 o; o.x = cvt_pk_bf16(s[0 * 33], s[1 * 33]); o.y = cvt_pk_bf16(s[2 * 33], s[3 * 33]); o.z = cvt_pk_bf16(s[4 * 33], s[5 * 33]); o.w = cvt_pk_bf16(s[6 * 33], s[7 * 33]);
        *(u32x4*)(WT + (size_t)(d0 + n) * K + k0 + 8 * c) = o; }
    lds_wait();
}
template <bool BF>
__device__ __forceinline__ void norm_rows(const float* src, const float* gain, void* dstv, int nrows, int gw, int ngw, int lane) {
    f32x4 gg[4];
#pragma unroll
    for (int j = 0; j < 4; ++j) gg[j] = ((const f32x4*)gain)[lane + 64 * j];
    for (int r = 4 * gw; r < nrows; r += 4 * ngw) {
        f32x4 v[4][4]; float sq[4];
#pragma unroll
        for (int i = 0; i < 4; ++i) { const f32x4* xr = (const f32x4*)(src + (size_t)(r + i) * D) + lane;
#pragma unroll
            for (int j = 0; j < 4; ++j) v[i][j] = xr[64 * j]; }
#pragma unroll
        for (int i = 0; i < 4; ++i) { float t = 0.f;
#pragma unroll
            for (int j = 0; j < 4; ++j) t += (v[i][j][0] * v[i][j][0] + v[i][j][1] * v[i][j][1]) + (v[i][j][2] * v[i][j][2] + v[i][j][3] * v[i][j][3]);
            sq[i] = t; }
#pragma unroll
        for (int o = 1; o < 64; o <<= 1) {
#pragma unroll
            for (int i = 0; i < 4; ++i) sq[i] += __shfl_xor(sq[i], o); }
#pragma unroll
        for (int i = 0; i < 4; ++i) { const float rstd = __builtin_amdgcn_rsqf(sq[i] * (1.f / D) + 1e-6f);
#pragma unroll
            for (int j = 0; j < 4; ++j) { const f32x4 y = v[i][j] * rstd * gg[j];
                if (BF) ((u32x2*)((bf16_t*)dstv + (size_t)(r + i) * D))[lane + 64 * j] = pack4(y); else ((f32x4*)((float*)dstv + (size_t)(r + i) * D))[lane + 64 * j] = y; } }
    }
}
struct F8 { f32x4 a, b; };
__device__ __forceinline__ F8 ld8_bf(const bf16_t* q) { const u32x4 a = *(const u32x4*)q; F8 o; o.a = (f32x4){bf_lo(a.x), bf_hi(a.x), bf_lo(a.y), bf_hi(a.y)}; o.b = (f32x4){bf_lo(a.z), bf_hi(a.z), bf_lo(a.w), bf_hi(a.w)}; return o; }
__device__ __forceinline__ F8 ld8_f(const float* q) { F8 o; o.a = *(const f32x4*)q; o.b = *(const f32x4*)(q + 4); return o; }
__device__ __forceinline__ void v_stats(const bf16_t* vp, int lane, float& mu, float& rstd) {
    const u32x4 a = *(const u32x4*)(vp + 8 * lane), b = *(const u32x4*)(vp + 512 + 8 * lane);
    const f32x4 x0 = {bf_lo(a.x), bf_hi(a.x), bf_lo(a.y), bf_hi(a.y)}, x1 = {bf_lo(a.z), bf_hi(a.z), bf_lo(a.w), bf_hi(a.w)};
    const f32x4 x2 = {bf_lo(b.x), bf_hi(b.x), bf_lo(b.y), bf_hi(b.y)}, x3 = {bf_lo(b.z), bf_hi(b.z), bf_lo(b.w), bf_hi(b.w)};
    const f32x4 sv = (x0 + x1) + (x2 + x3);
    mu = wave_sum((sv[0] + sv[1]) + (sv[2] + sv[3])) * (1.f / 1024.f);
    const f32x4 d0 = x0 - mu, d1 = x1 - mu, d2 = x2 - mu, d3 = x3 - mu;
    const f32x4 qv = (d0 * d0 + d1 * d1) + (d2 * d2 + d3 * d3);
    rstd = 1.f / sqrtf(wave_sum((qv[0] + qv[1]) + (qv[2] + qv[3])) * (1.f / 1024.f) + 1e-6f);
}

constexpr int VS = 136;
constexpr int KS = 528;
constexpr int KSK = 544;
template <int ROWS, bool SWZ = false, int STRIDE = 528>
__device__ __forceinline__ void stage_rows(const bf16_t* src, size_t gstride, LAS unsigned char* dst, int tid) {
    constexpr int N = ROWS * 32 / 512;
    u32x4 v[N];
#pragma unroll
    for (int i = 0; i < N; ++i) { const int idx = tid + 512 * i; v[i] = *(const u32x4*)(src + (size_t)(idx >> 5) * gstride + 8 * (idx & 31)); }
#pragma unroll
    for (int i = 0; i < N; ++i) { const int idx = tid + 512 * i, row = idx >> 5, cch = SWZ ? ((idx & 31) ^ (((row >> 4) & 3) << 2)) : (idx & 31);
        *(LAS u32x4*)(dst + row * STRIDE + 16 * cch) = v[i]; }
}
__device__ __forceinline__ void mixer_prompt(const Params& p, int l, int item, LAS unsigned char* lds, const int tid_in) {
    int tid = tid_in; asm volatile("" : "+v"(tid));
    const int w = __builtin_amdgcn_readfirstlane(tid >> 6), lane = tid & 63, fr = lane & 15, fq = lane >> 4;
    const int T = item >> 2, g = item & 3, r0 = T * 128, b = T >> 4, t0 = (T & 15) * 128;
    const bf16_t* P = (const bf16_t*)(p.ws + WS_P);
    LAS bf16_t* vnT = (LAS bf16_t*)lds;
    LAS float* stats = (LAS float*)(lds + 69632);
    LAS unsigned char* vts = lds + 71680;
    const int r = r0 + 16 * w + fr;
    bf16x8 pb[8];
    {
        bf16x8 qf[8];
#pragma unroll
        for (int k = 0; k < 8; ++k) qf[k] = *(const bf16x8*)(P + p_off(r, 5, g) + 32 * k + 8 * fq);
        stage_rows<256, false, KSK>((const bf16_t*)(p.ws + WS_KB) + (size_t)(b * 256) * D + 256 * g, D, lds, tid);
        __syncthreads();
        f32x4 sc[16];
        const LAS unsigned char* kp = lds + fr * KSK + 16 * fq;
        bf16x8 kfa[8], kfb[8];
#pragma unroll
        for (int k = 0; k < 8; ++k) kfa[k] = *(const LAS bf16x8*)(kp + 64 * k);
#pragma unroll
        for (int n = 0; n < 16; n += 2) {
#pragma unroll
            for (int k = 0; k < 8; ++k) kfb[k] = *(const LAS bf16x8*)(kp + (16 * (n + 1)) * KSK + 64 * k);
            __builtin_amdgcn_sched_barrier(0);
            { f32x4 a = {0.f, 0.f, 0.f, 0.f};
#pragma unroll
              for (int k = 0; k < 8; ++k) a = __builtin_amdgcn_mfma_f32_16x16x32_bf16(kfa[k], qf[k], a, 0, 0, 0);
              sc[n] = a; }
            __builtin_amdgcn_sched_barrier(0);
            if (n + 2 < 16) {
#pragma unroll
                for (int k = 0; k < 8; ++k) kfa[k] = *(const LAS bf16x8*)(kp + (16 * (n + 2)) * KSK + 64 * k); }
            __builtin_amdgcn_sched_barrier(0);
            { f32x4 a = {0.f, 0.f, 0.f, 0.f};
#pragma unroll
              for (int k = 0; k < 8; ++k) a = __builtin_amdgcn_mfma_f32_16x16x32_bf16(kfb[k], qf[k], a, 0, 0, 0);
              sc[n + 1] = a; }
            __builtin_amdgcn_sched_barrier(0);
        }
        float mx = -3.0e38f;
#pragma unroll
        for (int n = 0; n < 16; ++n) mx = fmaxf(fmaxf(mx, fmaxf(sc[n][0], sc[n][1])), fmaxf(sc[n][2], sc[n][3]));
        mx = fmaxf(mx, __shfl_xor(mx, 16)); mx = fmaxf(mx, __shfl_xor(mx, 32));
        float sum = 0.f;
#pragma unroll
        for (int n = 0; n < 16; ++n)
#pragma unroll
            for (int j = 0; j < 4; ++j) { const float e = __expf((sc[n][j] - mx) * 0.0625f); sc[n][j] = e; sum += e; }
        sum += __shfl_xor(sum, 16); sum += __shfl_xor(sum, 32);
        const float inv = 1.f / sum;
#pragma unroll
        for (int kk = 0; kk < 8; ++kk) pb[kk] = pack8(sc[2 * kk] * inv, sc[2 * kk + 1] * inv);
    }
    __syncthreads();
    if (tid < 128) { const f32x4* sp = (const f32x4*)((const float*)(p.ws + WS_ST) + ((size_t)l * MT + r0 + tid) * 32); f32x4 a4 = sp[0];
#pragma unroll
        for (int i = 1; i < 8; ++i) a4 += sp[i];
        const float mu = (a4[0] + a4[2]) * (1.f / 1024.f), var = fmaxf((a4[1] + a4[3]) * (1.f / 1024.f) - mu * mu, 0.f);
        stats[2 * tid] = mu; stats[2 * tid + 1] = 1.f / sqrtf(var + 1e-6f); }
    __syncthreads();
    const bf16_t* Vtg = (const bf16_t*)(p.ws + WS_VT) + ((size_t)(b * 4 + g) * 256) * 256;
    {
        const int s32 = lane & 31, j2 = lane >> 5;
        u32x4 raw[8];
#pragma unroll
        for (int i = 0; i < 8; ++i) { const int i4 = i >> 1, jj = i & 1; raw[i] = __builtin_nontemporal_load((const u32x4*)(P + p_off(r0 + 32 * i4 + s32, 4, g) + 8 * (4 * w + 2 * jj + j2))); }
        f32x4 gA[2], gB[2];
#pragma unroll
        for (int jj = 0; jj < 2; ++jj) { const float* lg = p.sg_ln_g + l * 1024 + 256 * g + 8 * (4 * w + 2 * jj + j2); gA[jj] = *(const f32x4*)lg; gB[jj] = *(const f32x4*)(lg + 4); }
#pragma unroll
        for (int i = 0; i < 8; ++i) { const int i4 = i >> 1, jj = i & 1, s = 32 * i4 + s32, j = 4 * w + 2 * jj + j2;
            const float mu = stats[2 * s], rstd = stats[2 * s + 1]; const f32x4 g0 = gA[jj], g1 = gB[jj];
            LAS bf16_t* d = vnT + (8 * j) * VS + s;
            d[0 * VS] = f2bf((bf_lo(raw[i].x) - mu) * rstd * g0[0]); d[1 * VS] = f2bf((bf_hi(raw[i].x) - mu) * rstd * g0[1]);
            d[2 * VS] = f2bf((bf_lo(raw[i].y) - mu) * rstd * g0[2]); d[3 * VS] = f2bf((bf_hi(raw[i].y) - mu) * rstd * g0[3]);
            d[4 * VS] = f2bf((bf_lo(raw[i].z) - mu) * rstd * g1[0]); d[5 * VS] = f2bf((bf_hi(raw[i].z) - mu) * rstd * g1[1]);
            d[6 * VS] = f2bf((bf_lo(raw[i].w) - mu) * rstd * g1[2]); d[7 * VS] = f2bf((bf_hi(raw[i].w) - mu) * rstd * g1[3]); }
        stage_rows<128, true>(Vtg, 256, vts, tid);
    }
    __syncthreads();
    const int tl = 16 * w + fr, kmax = w >> 1;
    bf16x8 wf[4];
    {
        const float* W = p.sg_w + ((size_t)(l * 4 + g) * 128 + tl) * 128 + 8 * fq;
        f32x4 wl0[4], wl1[4];
#pragma unroll
        for (int k = 0; k < 4; ++k) { wl0[k] = *(const f32x4*)(W + 32 * k); wl1[k] = *(const f32x4*)(W + 32 * k + 4); }
#pragma unroll
        for (int k = 0; k < 4; ++k) {
            f32x4 w0 = wl0[k], w1 = wl1[k];
            const int sb = 32 * k + 8 * fq;
#pragma unroll
            for (int i = 0; i < 4; ++i) { if (sb + i > tl) w0[i] = 0.f; if (sb + 4 + i > tl) w1[i] = 0.f; }
            wf[k] = pack8(w0, w1);
        }
    }
    {
        const float bs = p.sg_b[(l * 4 + g) * 128 + tl];
        const int tb = t0 + tl;
        const float* cw = p.conv_a_w + l * 3 * 1024 + 256 * g + 16 * fq;
        bf16_t* Y = (bf16_t*)(p.ws + WS_Y) + (size_t)r * D + 256 * g + 16 * fq;
        const bf16_t* pc = P + p_off(r, 0, g) + 16 * fq;
        const bf16_t* pcp = P + p_off(r >= 16 ? r - 16 : r, 0, g) + 16 * fq;
        constexpr size_t SEGS = (size_t)4 * 128 * 256;
        float* st = p.out + O_CAP + ((size_t)(l * 8 + b) * 2 + (tb - 2046)) * 1024 + 256 * g + 16 * fq;
        const f32x4 z4 = {0.f, 0.f, 0.f, 0.f};
        const bool ldprev = (fr >= 14) && (tb >= 16);
        struct S5 { u32x4 gm, gb, ga, u, bb, h2, c2, hp, cp; };
        auto load5 = [&](int sidx) -> S5 { const int co = 64 * (sidx >> 1) + 8 * (sidx & 1); S5 q;
            q.gm = *(const u32x4*)(pc + 8 * SEGS + co); q.gb = *(const u32x4*)(pc + 7 * SEGS + co); q.ga = *(const u32x4*)(pc + 6 * SEGS + co); q.u = *(const u32x4*)(pc + 3 * SEGS + co); q.bb = *(const u32x4*)(pc + 2 * SEGS + co);
            q.h2 = *(const u32x4*)(pc + co); q.c2 = *(const u32x4*)(pc + SEGS + co);
            const u32x4 zz = {0u, 0u, 0u, 0u};
            if (ldprev) { q.hp = *(const u32x4*)(pcp + co); q.cp = *(const u32x4*)(pcp + SEGS + co); } else { q.hp = zz; q.cp = zz; }
            return q; };
        auto up8 = [](const u32x4& a) -> F8 { F8 o; o.a = (f32x4){bf_lo(a.x), bf_hi(a.x), bf_lo(a.y), bf_hi(a.y)}; o.b = (f32x4){bf_lo(a.z), bf_hi(a.z), bf_lo(a.w), bf_hi(a.w)}; return o; };
        auto step5 = [&](const S5& q, int co, const f32x4& oa, const f32x4& ob, const f32x4& sga, const f32x4& sgb) {
            const F8 w0 = ld8_f(cw + co), w1 = ld8_f(cw + 1024 + co), w2 = ld8_f(cw + 2048 + co);
            const F8 h2 = up8(q.h2), c2 = up8(q.c2), hp = up8(q.hp), cp = up8(q.cp);
            const f32x4 ch2a = c2.a * h2.a, ch2b = c2.b * h2.b, chpa = cp.a * hp.a, chpb = cp.b * hp.b;
            f32x4 ch1a, ch1b, ch0a, ch0b;
#pragma unroll
            for (int j = 0; j < 4; ++j) { ch1a[j] = dpp_prev1(chpa[j], ch2a[j]); ch0a[j] = dpp_prev2(chpa[j], ch2a[j]); ch1b[j] = dpp_prev1(chpb[j], ch2b[j]); ch0b[j] = dpp_prev2(chpb[j], ch2b[j]); }
            const F8 bb = up8(q.bb);
            const f32x4 yaa = bb.a * (w0.a * ch0a + w1.a * ch1a + w2.a * ch2a), yab = bb.b * (w0.b * ch0b + w1.b * ch1b + w2.b * ch2b);
            const F8 gm = up8(q.gm), gb = up8(q.gb), ga = up8(q.ga), u = up8(q.u);
            f32x4 ya, yb;
#pragma unroll
            for (int j = 0; j < 4; ++j) { ya[j] = sigm(gm.a[j]) * oa[j] + sigm(gb.a[j]) * u.a[j] * (sga[j] + bs) + sigm(ga.a[j]) * yaa[j];
                yb[j] = sigm(gm.b[j]) * ob[j] + sigm(gb.b[j]) * u.b[j] * (sgb[j] + bs) + sigm(ga.b[j]) * yab[j]; }
            if (tb >= 2046) { *(f32x4*)(st + co) = ch2a; *(f32x4*)(st + co + 4) = ch2b; }
            u32x4 wv; wv.x = cvt_pk_bf16(ya[0], ya[1]); wv.y = cvt_pk_bf16(ya[2], ya[3]); wv.z = cvt_pk_bf16(yb[0], yb[1]); wv.w = cvt_pk_bf16(yb[2], yb[3]);
            *(u32x4*)(Y + co) = wv; };
        S5 cur = load5(0);
#pragma unroll 1
        for (int A = 0; A < 4; ++A) {
            if (A == 2) { __syncthreads(); stage_rows<128, true>(Vtg + 128 * 256, 256, vts, tid); __syncthreads(); }
            const int dbase = 64 * A + 16 * (fr >> 2) + (fr & 3);
            const S5 n1 = load5(2 * A + 1);
#pragma unroll
            for (int hlf = 0; hlf < 2; ++hlf) {
                f32x4 o[2], sa[2];
#pragma unroll
                for (int e = 0; e < 2; ++e) { f32x4 acc = z4; const LAS unsigned char* vrow = vts + ((dbase & 127) + 4 * (2 * hlf + e)) * KS + 8 * fq;
                    u32x4 vv[8];
#pragma unroll
                    for (int kk = 0; kk < 8; ++kk) { const int ko = 64 * (kk ^ (fr >> 2)); const u32x2 lo = *(const LAS u32x2*)(vrow + ko), hi = *(const LAS u32x2*)(vrow + ko + 32); vv[kk] = (u32x4){lo.x, lo.y, hi.x, hi.y}; }
                    __builtin_amdgcn_sched_barrier(0);
#pragma unroll
                    for (int kk = 0; kk < 8; ++kk) acc = __builtin_amdgcn_mfma_f32_16x16x32_bf16(__builtin_bit_cast(bf16x8, vv[kk]), pb[kk], acc, 0, 0, 0);
                    __builtin_amdgcn_sched_barrier(0);
                    o[e] = acc; }
#pragma unroll
                for (int e = 0; e < 2; ++e) { f32x4 acc = z4;
#pragma unroll
                    for (int k = 0; k < 4; ++k) if (k <= kmax) { const bf16x8 vf = *(const LAS bf16x8*)(vnT + (dbase + 4 * (2 * hlf + e)) * VS + 32 * k + 8 * fq); acc = __builtin_amdgcn_mfma_f32_16x16x32_bf16(vf, wf[k], acc, 0, 0, 0); }
                    sa[e] = acc; }
                if (hlf == 0) { step5(cur, 64 * A, o[0], o[1], sa[0], sa[1]); if (A < 3) cur = load5(2 * A + 2); }
                else step5(n1, 64 * A + 8, o[0], o[1], sa[0], sa[1]);
            }
        }
    }
    __syncthreads();
}

__device__ __forceinline__ void mixer_sample(const Params& p, int l, int item, LAS unsigned char* lds, const int tid_in) {
    int tid = tid_in; asm volatile("" : "+v"(tid));
    const int w = __builtin_amdgcn_readfirstlane(tid >> 6), lane = tid & 63, fr = lane & 15, fq = lane >> 4;
    const int s = item >> 2, g = item & 3, r0 = MP + 4 * s;
    const bf16_t* P = (const bf16_t*)(p.ws + WS_P);
    LAS float* st = (LAS float*)lds;
    LAS float* sc = (LAS float*)(lds + 1024);
    LAS float* pT = (LAS float*)(lds + 8192);
    LAS float* op = (LAS float*)(lds + 16384);
    if (tid < 4) { const f32x4* sp = (const f32x4*)((const float*)(p.ws + WS_ST) + ((size_t)l * MT + r0 + tid) * 32); f32x4 a4 = sp[0];
#pragma unroll
        for (int i = 1; i < 8; ++i) a4 += sp[i];
        const float mu = (a4[0] + a4[2]) * (1.f / 1024.f), var = fmaxf((a4[1] + a4[3]) * (1.f / 1024.f) - mu * mu, 0.f);
        st[2 * tid] = mu; st[2 * tid + 1] = 1.f / sqrtf(var + 1e-6f); }
    const size_t cbase = (((size_t)l * NSEQ + s) * 256 * 4 + g) * 256;
    {
        bf16x8 qf[8];
        const bf16_t* qp = P + p_off(r0 + (fr & 3), 5, g) + 8 * fq;
#pragma unroll
        for (int k = 0; k < 8; ++k) { qf[k] = *(const bf16x8*)(qp + 32 * k); if (fr >= 4) qf[k] = (bf16x8){0, 0, 0, 0, 0, 0, 0, 0}; }
        const float* Kc = p.cache_mem_k + cbase + (size_t)(32 * w + fr) * 1024 + 8 * fq;
        f32x4 kx[2][8][2];
#pragma unroll
        for (int nb = 0; nb < 2; ++nb)
#pragma unroll
            for (int k = 0; k < 8; ++k) { const float* kp = Kc + (size_t)(16 * nb) * 1024 + 32 * k;
                kx[nb][k][0] = __builtin_nontemporal_load((const f32x4*)kp); kx[nb][k][1] = __builtin_nontemporal_load((const f32x4*)(kp + 4)); }
        __builtin_amdgcn_sched_barrier(0);
#pragma unroll
        for (int nb = 0; nb < 2; ++nb) { f32x4 a = {0.f, 0.f, 0.f, 0.f};
#pragma unroll
            for (int k = 0; k < 8; ++k) a = __builtin_amdgcn_mfma_f32_16x16x32_bf16(pack8(kx[nb][k][0], kx[nb][k][1]), qf[k], a, 0, 0, 0);
            if (fr < 4) {
#pragma unroll
                for (int j = 0; j < 4; ++j) sc[fr * 256 + 32 * w + 16 * nb + 4 * fq + j] = a[j] * 0.0625f; } }
    }
    f32x4 vr[32];
    {
        const float* Vc = p.cache_mem_v + cbase + (size_t)(32 * w) * 1024 + 4 * lane;
#pragma unroll
        for (int mm = 0; mm < 32; ++mm) vr[mm] = __builtin_nontemporal_load((const f32x4*)(Vc + (size_t)mm * 1024));
    }
    __syncthreads();
    if (w < 4) {
        const f32x4 v = *(const LAS f32x4*)(sc + w * 256 + 4 * lane);
        const float mx = wave_max(fmaxf(fmaxf(v[0], v[1]), fmaxf(v[2], v[3])));
        f32x4 e = {__expf(v[0] - mx), __expf(v[1] - mx), __expf(v[2] - mx), __expf(v[3] - mx)};
        const float inv = 1.f / wave_sum((e[0] + e[1]) + (e[2] + e[3]));
#pragma unroll
        for (int i = 0; i < 4; ++i) pT[(4 * lane + i) * 4 + w] = e[i] * inv;
    }
    __syncthreads();
    {
        f32x4 o0 = {0.f, 0.f, 0.f, 0.f}, o1 = o0, o2 = o0, o3 = o0;
#pragma unroll
        for (int mm = 0; mm < 32; ++mm) { const f32x4 v = vr[mm]; const f32x4 pp = *(const LAS f32x4*)(pT + 4 * (32 * w + mm));
            o0 += pp[0] * v; o1 += pp[1] * v; o2 += pp[2] * v; o3 += pp[3] * v; }
        *(LAS f32x4*)(op + (w * 4 + 0) * 256 + 4 * lane) = o0; *(LAS f32x4*)(op + (w * 4 + 1) * 256 + 4 * lane) = o1;
        *(LAS f32x4*)(op + (w * 4 + 2) * 256 + 4 * lane) = o2; *(LAS f32x4*)(op + (w * 4 + 3) * 256 + 4 * lane) = o3;
    }
    __syncthreads();
    if (tid < 256) {
        const int cc = 256 * g + tid;
        constexpr size_t SEGS = (size_t)4 * 128 * 256;
        bf16_t pv[4][8];
#pragma unroll
        for (int t = 0; t < 4; ++t) { const bf16_t* q = P + p_off(r0 + t, 0, g) + tid;
            pv[t][0] = q[0]; pv[t][1] = q[SEGS]; pv[t][2] = q[2 * SEGS]; pv[t][3] = q[3 * SEGS]; pv[t][4] = q[4 * SEGS]; pv[t][5] = q[6 * SEGS]; pv[t][6] = q[7 * SEGS]; pv[t][7] = q[8 * SEGS]; }
        const float lg = p.sg_ln_g[l * 1024 + cc];
        const float* Wg = p.sg_w + (size_t)(l * 4 + g) * 128 * 128; const float* bg = p.sg_b + (l * 4 + g) * 128;
        const float cw0 = p.conv_a_w[l * 3072 + cc], cw1 = p.conv_a_w[l * 3072 + 1024 + cc], cw2 = p.conv_a_w[l * 3072 + 2048 + cc];
        float x[6];
        x[0] = p.cache_conv_a[((size_t)(l * NSEQ + s) * 2 + 0) * 1024 + cc]; x[1] = p.cache_conv_a[((size_t)(l * NSEQ + s) * 2 + 1) * 1024 + cc];
        const f32x4 wr0 = *(const f32x4*)(Wg), wr1 = *(const f32x4*)(Wg + 128), wr2 = *(const f32x4*)(Wg + 256), wr3 = *(const f32x4*)(Wg + 384), bgv = *(const f32x4*)bg;
        __builtin_amdgcn_sched_barrier(0);
        float ym[4];
#pragma unroll
        for (int t = 0; t < 4; ++t) { float a = 0.f;
#pragma unroll
            for (int ww = 0; ww < 8; ++ww) a += op[(ww * 4 + t) * 256 + tid];
            ym[t] = a; }
        float vn[4];
#pragma unroll
        for (int t = 0; t < 4; ++t) { vn[t] = (bf2f(pv[t][4]) - st[2 * t]) * st[2 * t + 1] * lg; x[2 + t] = bf2f(pv[t][1]) * bf2f(pv[t][0]); }
        const float sg0 = bgv[0] + wr0[0] * vn[0];
        const float sg1 = bgv[1] + wr1[0] * vn[0] + wr1[1] * vn[1];
        const float sg2 = bgv[2] + wr2[0] * vn[0] + wr2[1] * vn[1] + wr2[2] * vn[2];
        const float sg3 = bgv[3] + wr3[0] * vn[0] + wr3[1] * vn[1] + wr3[2] * vn[2] + wr3[3] * vn[3];
        const float sgv[4] = {sg0, sg1, sg2, sg3};
        float yv[4];
#pragma unroll
        for (int t = 0; t < 4; ++t) {
            const float yb = bf2f(pv[t][3]) * sgv[t];
            const float ya = bf2f(pv[t][2]) * (cw0 * x[t] + cw1 * x[t + 1] + cw2 * x[t + 2]);
            yv[t] = sigm(bf2f(pv[t][5])) * ya + sigm(bf2f(pv[t][6])) * yb + sigm(bf2f(pv[t][7])) * ym[t];
        }
        bf16_t* Y = (bf16_t*)(p.ws + WS_Y) + (size_t)r0 * D + cc;
#pragma unroll
        for (int t = 0; t < 4; ++t) { p.out[O_SV + ((size_t)(l * NSEQ + s) * 4 + t) * 1024 + cc] = vn[t]; Y[(size_t)t * D] = f2bf(yv[t]); }
        p.out[O_CAS + ((size_t)(l * NSEQ + s) * 2 + 0) * 1024 + cc] = x[4]; p.out[O_CAS + ((size_t)(l * NSEQ + s) * 2 + 1) * 1024 + cc] = x[5];
    }
    __syncthreads();
}

__device__ __forceinline__ F8 fma3(const F8& w0, const F8& x0, const F8& w1, const F8& x1, const F8& w2, const F8& x2, const F8& bb) {
    F8 o; o.a = w0.a * x0.a + w1.a * x1.a + w2.a * x2.a + bb.a; o.b = w0.b * x0.b + w1.b * x1.b + w2.b * x2.b + bb.b; return o; }
__device__ __forceinline__ void ffn_store(bf16_t* dst, const F8& av, const F8& gv) {
    u32x4 o;
    o.x = cvt_pk_bf16(silu_mul(gv.a[0], av.a[0]), silu_mul(gv.a[1], av.a[1])); o.y = cvt_pk_bf16(silu_mul(gv.a[2], av.a[2]), silu_mul(gv.a[3], av.a[3]));
    o.z = cvt_pk_bf16(silu_mul(gv.b[0], av.b[0]), silu_mul(gv.b[1], av.b[1])); o.w = cvt_pk_bf16(silu_mul(gv.b[2], av.b[2]), silu_mul(gv.b[3], av.b[3]));
    *(u32x4*)dst = o; }
__device__ __forceinline__ void ffn_elem(const Params& p, int l, int gw, int ngw, int lane) {
    const bf16_t* H = (const bf16_t*)(p.ws + WS_H); bf16_t* F = (bf16_t*)(p.ws + WS_F); const float* HB = (const float*)(p.ws + WS_HB);
    const float* cw = p.conv_f_w + (size_t)l * 3 * DFF2; const float* cb = p.conv_f_b + (size_t)l * DFF2;
    const f32x4 z4 = {0.f, 0.f, 0.f, 0.f};
    constexpr int NCB = 6;
    for (int it = gw; it < 256 * NCB; it += ngw) {
        const int gi = it / NCB, j = (it % NCB) * 64 + lane;
        if (j >= 352) continue;
        const int col = 8 * j; const bool first = (gi & 31) == 0;
        const F8 wa0 = ld8_f(cw + col), wa1 = ld8_f(cw + DFF2 + col), wa2 = ld8_f(cw + 2 * DFF2 + col), ba = ld8_f(cb + col);
        const F8 wg0 = ld8_f(cw + DFF + col), wg1 = ld8_f(cw + DFF2 + DFF + col), wg2 = ld8_f(cw + 2 * DFF2 + DFF + col), bg = ld8_f(cb + DFF + col);
        const float* hb = HB + (size_t)gi * 4 * DFF2 + col;
        F8 a0, a1, g0, g1;
        if (!first) { a0 = ld8_f(hb - 2 * DFF2); g0 = ld8_f(hb - 2 * DFF2 + DFF); a1 = ld8_f(hb - DFF2); g1 = ld8_f(hb - DFF2 + DFF); }
        else { a0.a = z4; a0.b = z4; a1 = a0; g0 = a0; g1 = a0; }
        const F8 xa0 = ld8_f(hb), xg0 = ld8_f(hb + DFF), xa1 = ld8_f(hb + DFF2), xg1 = ld8_f(hb + DFF2 + DFF);
        bf16_t* fp = F + (size_t)(64 * gi) * DFF + col;
        ffn_store(fp, fma3(wa0, a0, wa1, a1, wa2, xa0, ba), fma3(wg0, g0, wg1, g1, wg2, xg0, bg));
        ffn_store(fp + DFF, fma3(wa0, a1, wa1, xa0, wa2, xa1, ba), fma3(wg0, g1, wg1, xg0, wg2, xg1, bg));
    }
    for (int it = gw; it < NSEQ * NCB; it += ngw) {
        const int sq = it / NCB, j = (it % NCB) * 64 + lane;
        if (j >= 352) continue;
        const int col = 8 * j, rq = MP + 4 * sq;
        const F8 wa0 = ld8_f(cw + col), wa1 = ld8_f(cw + DFF2 + col), wa2 = ld8_f(cw + 2 * DFF2 + col), ba = ld8_f(cb + col);
        const F8 wg0 = ld8_f(cw + DFF + col), wg1 = ld8_f(cw + DFF2 + DFF + col), wg2 = ld8_f(cw + 2 * DFF2 + DFF + col), bg = ld8_f(cb + DFF + col);
        const float* cc = p.cache_conv_ffn + ((size_t)(l * NSEQ + sq) * 2) * DFF2 + col;
        const F8 a0 = ld8_f(cc), g0 = ld8_f(cc + DFF), a1 = ld8_f(cc + DFF2), g1 = ld8_f(cc + DFF2 + DFF);
        const bf16_t* hp = H + (size_t)rq * DFF2 + col;
        const F8 xa0 = ld8_bf(hp), xg0 = ld8_bf(hp + DFF), xa1 = ld8_bf(hp + DFF2), xg1 = ld8_bf(hp + DFF2 + DFF);
        const F8 xa2 = ld8_bf(hp + 2 * DFF2), xg2 = ld8_bf(hp + 2 * DFF2 + DFF), xa3 = ld8_bf(hp + 3 * DFF2), xg3 = ld8_bf(hp + 3 * DFF2 + DFF);
        bf16_t* fp = F + (size_t)rq * DFF + col;
        ffn_store(fp, fma3(wa0, a0, wa1, a1, wa2, xa0, ba), fma3(wg0, g0, wg1, g1, wg2, xg0, bg));
        ffn_store(fp + DFF, fma3(wa0, a1, wa1, xa0, wa2, xa1, ba), fma3(wg0, g1, wg1, xg0, wg2, xg1, bg));
        ffn_store(fp + 2 * DFF, fma3(wa0, xa0, wa1, xa1, wa2, xa2, ba), fma3(wg0, xg0, wg1, xg1, wg2, xg2, bg));
        ffn_store(fp + 3 * DFF, fma3(wa0, xa1, wa1, xa2, wa2, xa3, ba), fma3(wg0, xg1, wg1, xg2, wg2, xg3, bg));
    }
}

__device__ __forceinline__ int lane_id() { unsigned z = 0u; asm volatile("" : "+v"(z)); return (int)__builtin_amdgcn_mbcnt_hi(~0u, __builtin_amdgcn_mbcnt_lo(~0u, z)); }
#define XB_TMO      128
#define XB_XCNT(j)  (256  + 64 * (j))
#define XB_XSUB(j)  (1280 + 64 * (j))
#define XB_XGEN(j)  (2304 + 64 * (j))
#define XB_TOP      3328
#define XB_TOPGEN   3392
#define XCD_BAR_WORDS 3456
#define XB_SPIN_CAP (1u << 18)
__device__ __forceinline__ unsigned xb_ld(unsigned* p)              { return __hip_atomic_load(p, __ATOMIC_RELAXED, __HIP_MEMORY_SCOPE_AGENT); }
__device__ __forceinline__ unsigned xb_add(unsigned* p, unsigned v) { return __hip_atomic_fetch_add(p, v, __ATOMIC_RELAXED, __HIP_MEMORY_SCOPE_AGENT); }
__device__ __forceinline__ unsigned xb_xcc_id() { return (unsigned)__builtin_amdgcn_s_getreg((3 << 11) | 20) & 0xFu; }
#define XB_SPIN(cond, bar) do { unsigned _sp = 0; while (cond) { __builtin_amdgcn_s_sleep(1); \
    if ((++_sp & 255u) == 0u) { if (xb_ld(&(bar)[XB_TMO])) break; if (_sp > XB_SPIN_CAP) { atomicAdd(&(bar)[XB_TMO], 1u); break; } } } } while (0)
struct XcdBarrier { unsigned* bar; unsigned x; volatile LAS unsigned* st; };
__device__ __forceinline__ XcdBarrier xcd_barrier_post(unsigned* bar, volatile LAS unsigned* st, bool leader) {
    XcdBarrier b; b.bar = bar; b.x = xb_xcc_id(); b.st = st;
    if (leader) (void)xb_add(&bar[XB_XCNT(b.x)], 1u);
    return b;
}
__device__ __forceinline__ void xcd_barrier_complete(unsigned* bar, unsigned x, unsigned& nloc, unsigned& nx) {
    const unsigned G = gridDim.x * gridDim.y * gridDim.z;
    unsigned sum, cnt, mine, sp = 0u;
    for (;;) {
        sum = 0u; cnt = 0u; mine = 0u;
#pragma unroll
        for (unsigned j = 0; j < 16; ++j) { const unsigned c = xb_ld(&bar[XB_XCNT(j)]); sum += c; cnt += (c > 0u) ? 1u : 0u; mine = (j == x) ? c : mine; }
        if (sum == G) break;
        __builtin_amdgcn_s_sleep(1);
        if ((++sp & 255u) == 0u) { if (xb_ld(&bar[XB_TMO])) break; if (sp > XB_SPIN_CAP) { atomicAdd(&bar[XB_TMO], 1u); break; } }
    }
    nloc = mine > 0u ? mine : 1u; nx = cnt > 0u ? cnt : 1u;
}
__device__ __forceinline__ void xcd_barrier(const XcdBarrier& b, const int wave0) {
    asm volatile("s_waitcnt vmcnt(0)" ::: "memory");
    __syncthreads();
    if (wave0 == 0 && lane_id() == 0) {
        unsigned* bar = b.bar; asm volatile("" : "+s"(bar));
        unsigned bx = b.x; asm volatile("" : "+s"(bx));
        __builtin_amdgcn_s_waitcnt(0);
        unsigned nloc = b.st[0], nx = b.st[1];
        if (nloc == 0u) { xcd_barrier_complete(bar, bx, nloc, nx); b.st[0] = nloc; b.st[1] = nx; }
        const unsigned old = xb_add(&bar[XB_XSUB(bx)], 1u);
        const unsigned gen = old / nloc;
        if (old + 1u == (gen + 1u) * nloc) {
            __builtin_amdgcn_fence(__ATOMIC_RELEASE, "agent");
            asm volatile("s_waitcnt vmcnt(0)" ::: "memory");
            const unsigned og = xb_add(&bar[XB_TOP], 1u);
            const unsigned tg = og / nx;
            if (og + 1u == (tg + 1u) * nx) xb_add(&bar[XB_TOPGEN], 1u);
            else XB_SPIN(xb_ld(&bar[XB_TOPGEN]) == tg, bar);
            __builtin_amdgcn_fence(__ATOMIC_ACQUIRE, "agent");
            xb_add(&bar[XB_XGEN(bx)], 1u);
            asm volatile("s_waitcnt vmcnt(0)" ::: "memory");
        } else {
            XB_SPIN(xb_ld(&bar[XB_XGEN(bx)]) == gen, bar);
            __builtin_amdgcn_fence(__ATOMIC_ACQUIRE, "agent");
            asm volatile("s_waitcnt vmcnt(0)" ::: "memory");
        }
    }
    __syncthreads();
}

__global__ void __launch_bounds__(512, 2) fwd_megakernel(Params p) {
    extern __shared__ __attribute__((aligned(16))) unsigned char shm[];
    LAS unsigned char* lds = (LAS unsigned char*)shm;
    cg::grid_group grid = cg::this_grid();
    volatile LAS unsigned* xb_st = (volatile LAS unsigned*)(lds + LDS_BYTES - 16);
    const int wave0 = __builtin_amdgcn_readfirstlane((int)threadIdx.x >> 6);
    const bool leader0 = (wave0 == 0) && (lane_id() == 0);
    if (leader0) { xb_st[0] = 0u; xb_st[1] = 0u; }
    __syncthreads();
    const XcdBarrier xb = xcd_barrier_post((unsigned*)(p.ws + WS_BAR), xb_st, leader0);
    const int G = gridDim.x, c = blockIdx.x, ngw = G * 8;
    bf16_t* WT = (bf16_t*)(p.ws + WS_WT);
    bf16_t* ZA = (bf16_t*)(p.ws + WS_ZA);
    float* X = (float*)(p.ws + WS_X);

#pragma unroll 1
    for (int rep0 = 0; rep0 < (((DUP_MASK >> 8) & 1) ? 2 : 1); ++rep0) {
        const int lane = lane_id(), wave = wave0, tid = wave0 * 64 + lane, gw = c * 8 + wave;
        LAS float* scr = (LAS float*)(lds + wave * 8448);
        constexpr int I_IN = 16 * (DIN / 32), I_K = 16 * 32, I_O = 16 * 32, I_UP = 16 * (DFF2 / 32), I_DN = (DFF / 64) * 32, I_L = I_IN + 2 * I_K + I_O + I_UP + I_DN;
        for (int it = gw; it < 2 * I_L; it += ngw) {
            const int l = it / I_L; int r = it % I_L; bf16_t* wl = WT + (size_t)l * WL_SZ;
            if (r < I_IN) { transpose_item(p.w_in + (size_t)l * D * DIN, D, DIN, wl + WL_IN, scr, r, lane); continue; } r -= I_IN;
            if (r < I_K) { transpose_item(p.w_k + (size_t)l * D * D, D, D, wl + WL_KV, scr, r, lane); continue; } r -= I_K;
            if (r < I_K) { transpose_item(p.w_v + (size_t)l * D * D, D, D, wl + WL_KV + (size_t)D * D, scr, r, lane); continue; } r -= I_K;
            if (r < I_O) { transpose_item(p.w_o + (size_t)l * D * D, D, D, wl + WL_O, scr, r, lane); continue; } r -= I_O;
            if (r < I_UP) { transpose_item(p.w_up + (size_t)l * D * DFF2, D, DFF2, wl + WL_UP, scr, r, lane, true); continue; } r -= I_UP;
            transpose_item(p.w_down + (size_t)l * DFF * D, DFF, D, wl + WL_DN, scr, r, lane);
        }
        norm_rows<true>(p.x_prompt, p.norm_mix_g, ZA, MP, gw, ngw, lane);
        norm_rows<true>(p.x_sample, p.norm_mix_g, ZA + (size_t)MP * D, MS, gw, ngw, lane);
        norm_rows<true>(p.mem_prompt, p.norm_mem_g, ZA + (size_t)MT * D, MMEM, gw, ngw, lane);
    }
    if (p.ws == nullptr) grid.sync();
    xcd_barrier(xb, wave0);

#pragma unroll 1
    for (int ph = 0; ph < 16; ++ph) {
        const int l = ph >> 3, sub = ph & 7;
        const bf16_t* wl = WT + (size_t)l * WL_SZ;
        const int nrep = ((DUP_MASK >> sub) & 1) ? 2 : 1;
#pragma unroll 1
        for (int rep = 0; rep < nrep; ++rep) {
        if (rep) xcd_barrier(xb, wave0);
        int lane = lane_id(); asm volatile("" : "+v"(lane));
        const int wave = wave0, tid = wave0 * 64 + lane, gw = c * 8 + wave;
        if (sub == 0 || sub == 4) {
            Gemm g; Sched S; EpiB E;
            S.G = G; S.c = c; S.nM = MT / BM; E.l = l; E.KB = (bf16_t*)(p.ws + WS_KB); E.VT = (bf16_t*)(p.ws + WS_VT); E.out = p.out; E.ST = (float*)(p.ws + WS_ST); E.Fo = (bf16_t*)(p.ws + WS_F); E.HB = (float*)(p.ws + WS_HB); E.cw = p.conv_f_w + (size_t)l * 3 * DFF2; E.cb = p.conv_f_b + (size_t)l * DFF2; g.K = D; g.A = ZA;
            if (sub == 0) { g.Bt = wl + WL_IN; S.nN = DIN / BM; S.extra = 64; S.xpm0 = MT / BM; S.xpn0 = DIN / BM; E.mode = 0; E.O = (bf16_t*)(p.ws + WS_P); E.ldc = DIN; }
            else { g.Bt = wl + WL_UP; S.nN = DFF2 / BM; S.extra = 0; S.xpm0 = 0; S.xpn0 = 0; E.mode = 1; E.O = (bf16_t*)(p.ws + WS_H); E.ldc = DFF2; }
            S.nwg = S.nM * S.nN;
            gemm_phase<EpiB>(lds, tid, g, S, E);
        } else if (sub == 2 || sub == 6) {
            Gemm g; Sched S; EpiRes E;
            S.G = G; S.c = c; S.nM = MP / BM; S.nN = D / BM; S.nwg = S.nM * S.nN; S.extra = 0; S.xpm0 = 0; S.xpn0 = 0;
            E.dst = X; E.src_p = X; E.src_s = X + (size_t)MP * D;
            if (sub == 2) { g.A = (const bf16_t*)(p.ws + WS_Y); g.Bt = wl + WL_O; g.K = D; if (l == 0) { E.src_p = p.x_prompt; E.src_s = p.x_sample; } }
            else { g.A = (const bf16_t*)(p.ws + WS_F); g.Bt = wl + WL_DN; g.K = DFF; }
            if (nrep == 2 && rep == 0) E.dst = (float*)(p.ws + WS_H);
            gemm_phase<EpiRes>(lds, tid, g, S, E);
            for (int uu = c; uu < 256; uu += G) small_gemm_res(g.A + (size_t)MP * g.K, g.Bt, g.K, E.src_s, E.dst + (size_t)MP * D, uu, tid, lds);
        } else if (sub == 1) {
            for (int k = 0; k < 4; ++k) {
                const int kk = k ^ 2;
                const int item = c + (kk & 1) * G;
#ifdef DUP_MIX_MODE
                if (nrep == 2 && rep == 0 && ((kk < 2) != (DUP_MIX_MODE == 1))) continue;
#endif
                if (item < 512) { if (kk < 2) mixer_prompt(p, l, item, lds, tid); else mixer_sample(p, l, item, lds, tid); }
            }
            for (int item = c + 2 * G; item < 512; item += G) { mixer_prompt(p, l, item, lds, tid); mixer_sample(p, l, item, lds, tid); }
        } else if (sub == 3) {
            norm_rows<true>(X, p.norm_ffn_g + l * D, ZA, MT, gw, ngw, lane);
        } else if (sub == 5) {
            ffn_elem(p, l, gw, ngw, lane);
        } else {
            if (l == 0) { norm_rows<true>(X, p.norm_mix_g + D, ZA, MT, gw, ngw, lane); norm_rows<true>(p.mem_prompt, p.norm_mem_g + D, ZA + (size_t)MT * D, MMEM, gw, ngw, lane); }
            else norm_rows<false>(X, p.norm_final_g, p.out + O_YP, MT, gw, ngw, lane);
        }
        }
#ifdef EXTRA_SYNCS
        for (int es = 0; es < EXTRA_SYNCS; ++es) xcd_barrier(xb, wave0);
#endif
        if (ph < 15) xcd_barrier(xb, wave0);
    }
}

extern "C" void kernel_launch(void* const* d_in, const int* in_sizes, int n_in, void* d_out, int out_size, void* d_ws, size_t ws_size, hipStream_t stream) {
    static int grid_blocks = 0;
    if (grid_blocks == 0) {
        if (n_in != 23 || ws_size < WS_END) { fprintf(stderr, "kernel_launch: unexpected n_in %d or ws_size %zu (< %zu)\n", n_in, ws_size, (size_t)WS_END); grid_blocks = -1; return; }
        int dev = 0, cus = 0, per_cu = 0;
        hipGetDevice(&dev);
        hipDeviceGetAttribute(&cus, hipDeviceAttributeMultiprocessorCount, dev);
        hipFuncSetAttribute((const void*)fwd_megakernel, hipFuncAttributeMaxDynamicSharedMemorySize, LDS_BYTES);
        hipOccupancyMaxActiveBlocksPerMultiprocessor(&per_cu, (const void*)fwd_megakernel, 512, LDS_BYTES);
        if (per_cu < 1) { fprintf(stderr, "kernel_launch: occupancy query reports %d blocks per CU\n", per_cu); grid_blocks = -1; return; }
        grid_blocks = cus;
    }
    if (grid_blocks < 0) return;
    if (hipMemsetAsync((char*)d_ws + WS_BAR, 0, 16384, stream) != hipSuccess) { fprintf(stderr, "kernel_launch: memset of the barrier words failed\n"); return; }
    Params p{};
    const float** pp = (const float**)&p;
    for (int i = 0; i < 23; ++i) pp[i] = (const float*)d_in[i];
    p.out = (float*)d_out; p.ws = (unsigned char*)d_ws;
    void* args[] = {&p};
    hipError_t e = hipLaunchCooperativeKernel((const void*)fwd_megakernel, dim3(grid_blocks), dim3(512), args, LDS_BYTES, stream);
    if (e != hipSuccess) fprintf(stderr, "cooperative launch failed: %s (grid %d)\n", hipGetErrorString(e), grid_blocks);
}
```

```cpp
#include <hip/hip_runtime.h>
#include <hip/hip_cooperative_groups.h>
#include <cstdio>
namespace cg = cooperative_groups;

#define LAS __attribute__((address_space(3)))
typedef unsigned short bf16_t;
typedef short bf16x8 __attribute__((ext_vector_type(8)));
typedef float f32x4 __attribute__((ext_vector_type(4)));
typedef unsigned u32x4 __attribute__((ext_vector_type(4)));
typedef unsigned u32x2 __attribute__((ext_vector_type(2)));

constexpr int D = 1024, MP = 16384, MS = 512, MT = MP + MS, MMEM = 2048, DIN = 9216, DFF = 2816, DFF2 = 5632;
constexpr int NSEQ = 128;
constexpr size_t O_YP = 0, O_CAP = 17301504, O_CFP = 17334272, O_MK = 17514496, O_MV = 21708800, O_CAS = 25903104, O_CFS = 26427392, O_SV = 29310976;
constexpr size_t WL_IN = 0, WL_KV = (size_t)DIN * D, WL_O = WL_KV + (size_t)2048 * D, WL_UP = WL_O + (size_t)D * D, WL_DN = WL_UP + (size_t)DFF2 * D, WL_SZ = WL_DN + (size_t)D * DFF;
constexpr size_t WS_WT = 0;
constexpr size_t WS_ZA = WS_WT + 2 * WL_SZ * 2;
constexpr size_t WS_Y = WS_ZA + (size_t)(MT + MMEM) * D * 2;
constexpr size_t WS_X = WS_Y + (size_t)MT * D * 2;
constexpr size_t WS_KB = WS_X + (size_t)MT * D * 4;
constexpr size_t WS_VT = WS_KB + (size_t)MMEM * D * 2;
constexpr size_t WS_P = WS_VT + (size_t)MMEM * D * 2;
constexpr size_t WS_H = WS_P;
constexpr size_t WS_F = WS_H + (size_t)MT * DFF2 * 2;
constexpr size_t WS_ST = WS_P + (size_t)MT * DIN * 2;
constexpr size_t WS_BAR = WS_ST + (size_t)2 * MT * 16 * 2 * 4;
constexpr size_t WS_HB = WS_BAR + 16384;
constexpr size_t WS_END = WS_HB + (size_t)256 * 4 * DFF2 * 4;
constexpr int LDS_BYTES = 160 * 1024;
#ifndef DUP_MASK
#define DUP_MASK 0
#endif

struct Params {
    const float *x_prompt, *x_sample, *mem_prompt, *cache_conv_a, *cache_conv_ffn, *cache_mem_k, *cache_mem_v, *norm_mix_g, *w_in, *conv_a_w, *sg_ln_g, *sg_w, *sg_b,
        *norm_mem_g, *w_k, *w_v, *w_o, *norm_ffn_g, *w_up, *conv_f_w, *conv_f_b, *w_down, *norm_final_g;
    float* out; unsigned char* ws;
};

__device__ __forceinline__ unsigned cvt_pk_bf16(float lo, float hi) { unsigned r; asm("v_cvt_pk_bf16_f32 %0, %1, %2" : "=v"(r) : "v"(lo), "v"(hi)); return r; }
__device__ __forceinline__ float bf_lo(unsigned u) { return __uint_as_float(u << 16); }
__device__ __forceinline__ float bf_hi(unsigned u) { return __uint_as_float(u & 0xffff0000u); }
__device__ __forceinline__ float bf2f(bf16_t b) { return __uint_as_float(((unsigned)b) << 16); }
__device__ __forceinline__ bf16_t f2bf(float f) { return (bf16_t)(cvt_pk_bf16(f, 0.f) & 0xffffu); }
__device__ __forceinline__ f32x4 unpack4(u32x2 u) { return (f32x4){bf_lo(u.x), bf_hi(u.x), bf_lo(u.y), bf_hi(u.y)}; }
__device__ __forceinline__ u32x2 pack4(f32x4 v) { u32x2 r; r.x = cvt_pk_bf16(v[0], v[1]); r.y = cvt_pk_bf16(v[2], v[3]); return r; }
__device__ __forceinline__ bf16x8 pack8(f32x4 a, f32x4 b) { u32x4 w; w.x = cvt_pk_bf16(a[0], a[1]); w.y = cvt_pk_bf16(a[2], a[3]); w.z = cvt_pk_bf16(b[0], b[1]); w.w = cvt_pk_bf16(b[2], b[3]); return __builtin_bit_cast(bf16x8, w); }
__device__ __forceinline__ float sigm(float x) { return __builtin_amdgcn_rcpf(1.f + __expf(-x)); }
__device__ __forceinline__ float wave_sum(float v) {
#pragma unroll
    for (int o = 1; o < 64; o <<= 1) v += __shfl_xor(v, o);
    return v;
}
__device__ __forceinline__ float wave_max(float v) {
#pragma unroll
    for (int o = 1; o < 64; o <<= 1) v = fmaxf(v, __shfl_xor(v, o));
    return v;
}
__device__ __forceinline__ void lds_wait() { asm volatile("s_waitcnt lgkmcnt(0)" ::: "memory"); }

constexpr int BM = 256, BK = 64, HALF = 128, HTB = HALF * BK * 2, NXCD = 8, WGM = 5;
__device__ __forceinline__ int lds_byte(int r, int c) { const int st = (r >> 4) * 2 + (c >> 5), rr = r & 15, cc = c & 31, ob = rr * 64 + cc * 2; return st * 1024 + (ob ^ (((ob >> 9) & 1) << 5)); }
__device__ __forceinline__ void stage_rc(int b, int& R, int& C) { const int st = b / 1024, sb = b % 1024, swz = sb ^ (((sb >> 9) & 1) << 5); R = (st >> 1) * 16 + swz / 64; C = (st & 1) * 32 + (swz % 64) / 2; }
__device__ __forceinline__ int perm32(int rho) { const int n = rho >> 4, i = rho & 15; return 8 * (i >> 2) + 4 * n + (i & 3); }
struct Unit { int pm, pn; };
struct Gemm { const bf16_t* A; const bf16_t* Bt; int K; };
struct Sched {
    int nM, nN, nwg, extra, xpm0, xpn0, G, c;
    __device__ __forceinline__ bool next(int i, Unit& u) const {
        const int L = i * G + c;
        if (L >= nwg + extra) return false;
        if (L >= nwg) { const int q = L - nwg; u.pm = xpm0 + (q >> 3); u.pn = xpn0 + (q & 7); return true; }
        int wgid = L; { const int q = nwg / NXCD, r = nwg % NXCD, xcd = wgid % NXCD, off = wgid / NXCD; wgid = (xcd < r ? xcd * (q + 1) : r * (q + 1) + (xcd - r) * q) + off; }
        const int nig = WGM * nN, gid = wgid / nig, fm = gid * WGM, gsz = (nM - fm) < WGM ? (nM - fm) : WGM;
        u.pm = fm + ((wgid % nig) % gsz); u.pn = (wgid % nig) / gsz; return true;
    }
};

template <class Epi>
__device__ __forceinline__ void gemm_phase(LAS unsigned char* lds, const int tid, const Gemm g, const Sched& S, const Epi& E) {
    const int wid = __builtin_amdgcn_readfirstlane(tid >> 6), lane = tid & 63, wr = wid >> 2, wc = wid & 3, fr = lane & 15, fq = lane >> 4;
    const int K = g.K, nt = K / BK;
    unsigned voffA[2], voffB[2];
#pragma unroll
    for (int i = 0; i < 2; ++i) { int R, C; stage_rc(tid * 16 + i * 8192, R, C); const int Rb = Epi::PERM ? ((R & ~31) + perm32(R & 31)) : R;
        voffA[i] = (unsigned)(R * K + C) * 2u; voffB[i] = (unsigned)(Rb * K + C) * 2u; }
    const size_t kstep = (size_t)(BK * 2);
    const size_t hstep = (size_t)HALF * K * 2;
    const size_t tstep = 2 * hstep;
    const unsigned ldsw = (unsigned)wid * 1024u;
    const int aoff = lds_byte(wr * 64 + fr, fq * 8), boff = lds_byte(wc * 32 + fr, fq * 8);
#define PG8_SA(b, h) (((b) * 2 + (h)) * HTB)
#define PG8_SB(b, h) ((4 + (b) * 2 + (h)) * HTB)
#define PG8_STAGE(bufoff, gbase, voff) do { _Pragma("unroll") for (int _i = 0; _i < 2; ++_i) \
        __builtin_amdgcn_global_load_lds((const unsigned*)((const char*)(gbase) + (voff)[_i]), (LAS unsigned*)(lds + (bufoff) + ldsw + _i * 8192), 16, 0, 0); } while (0)
#define PG8_LDA(dst, b, h) do { _Pragma("unroll") for (int m = 0; m < 4; ++m) _Pragma("unroll") for (int k = 0; k < 2; ++k) dst[m][k] = *(const LAS bf16x8*)(lds + PG8_SA(b, h) + aoff + m * 2048 + k * 1024); } while (0)
#define PG8_LDB(dst, b, h) do { _Pragma("unroll") for (int n = 0; n < 2; ++n) _Pragma("unroll") for (int k = 0; k < 2; ++k) dst[n][k] = *(const LAS bf16x8*)(lds + PG8_SB(b, h) + boff + n * 2048 + k * 1024); } while (0)
#define PG8_MMA(ai, bj, At, Bt) do { __builtin_amdgcn_s_setprio(1); _Pragma("unroll") for (int m = 0; m < 4; ++m) _Pragma("unroll") for (int n = 0; n < 2; ++n) _Pragma("unroll") for (int k = 0; k < 2; ++k) \
        acc[ai][bj][m][n] = __builtin_amdgcn_mfma_f32_16x16x32_bf16(Bt[n][k], At[m][k], acc[ai][bj][m][n], 0, 0, 0); __builtin_amdgcn_s_setprio(0); } while (0)
#define PG8_WAIT_V(n) asm volatile("s_waitcnt vmcnt(" #n ")" ::: "memory")
#define PG8_WAIT_L(n) asm volatile("s_waitcnt lgkmcnt(" #n ")" ::: "memory")
#define PG8_BAR __builtin_amdgcn_s_barrier()
#define PG8_SCHED __builtin_amdgcn_sched_barrier(0)
    Unit cur, nxt; int ui = 0;
    if (!S.next(0, cur)) return;
    f32x4 acc[2][2][4][2];
#pragma unroll
    for (int a = 0; a < 2; ++a)
#pragma unroll
        for (int b = 0; b < 2; ++b)
#pragma unroll
            for (int m = 0; m < 4; ++m)
#pragma unroll
                for (int n = 0; n < 2; ++n) acc[a][b][m][n] = (f32x4){0.f, 0.f, 0.f, 0.f};
    bf16x8 At[4][2], B0[2][2], B1[2][2];
    const char* cA = (const char*)g.A + (size_t)cur.pm * tstep; const char* cB = (const char*)g.Bt + (size_t)cur.pn * tstep;
    PG8_STAGE(PG8_SB(0, 0), cB, voffB); PG8_STAGE(PG8_SA(0, 0), cA, voffA); PG8_STAGE(PG8_SB(0, 1), cB + hstep, voffB); PG8_STAGE(PG8_SA(0, 1), cA + hstep, voffA);
    if (wr == 1) PG8_BAR;
    PG8_WAIT_V(4); PG8_BAR;
    PG8_STAGE(PG8_SB(1, 0), cB + kstep, voffB); PG8_STAGE(PG8_SA(1, 0), cA + kstep, voffA); PG8_STAGE(PG8_SB(1, 1), cB + hstep + kstep, voffB);
    PG8_WAIT_V(6); PG8_BAR;
    for (;;) {
        const bool has_next = S.next(ui + 1, nxt);
        const char* nA = has_next ? (const char*)g.A + (size_t)nxt.pm * tstep : cA; const char* nB = has_next ? (const char*)g.Bt + (size_t)nxt.pn * tstep : cB;
        for (int t = 0; t < nt; t += 2) {
            const bool last = (t == nt - 2);
            const char* a1 = cA + (size_t)(t + 1) * kstep;
            const char* a2 = last ? nA : cA + (size_t)(t + 2) * kstep; const char* b2 = last ? nB : cB + (size_t)(t + 2) * kstep;
            const char* a3 = a2 + kstep; const char* b3 = b2 + kstep;
            PG8_LDB(B0, 0, 0); PG8_SCHED; PG8_LDA(At, 0, 0); PG8_STAGE(PG8_SA(1, 1), a1 + hstep, voffA);
            PG8_WAIT_L(8); PG8_BAR; PG8_WAIT_L(0); PG8_MMA(0, 0, At, B0); PG8_BAR; PG8_SCHED;
            PG8_LDB(B1, 0, 1); PG8_STAGE(PG8_SB(0, 0), b2, voffB);
            PG8_BAR; PG8_WAIT_L(0); PG8_MMA(0, 1, At, B1); PG8_BAR;
            PG8_LDA(At, 0, 1); PG8_STAGE(PG8_SA(0, 0), a2, voffA);
            PG8_BAR; PG8_WAIT_L(0); PG8_MMA(1, 0, At, B0); PG8_BAR; PG8_SCHED;
            PG8_STAGE(PG8_SB(0, 1), b2 + hstep, voffB);
            PG8_WAIT_V(6); PG8_BAR; PG8_MMA(1, 1, At, B1); PG8_BAR;
            PG8_LDB(B0, 1, 0); PG8_SCHED; PG8_LDA(At, 1, 0); PG8_STAGE(PG8_SA(0, 1), a2 + hstep, voffA);
            PG8_WAIT_L(8); PG8_BAR; PG8_WAIT_L(0); PG8_MMA(0, 0, At, B0); PG8_BAR; PG8_SCHED;
            PG8_LDB(B1, 1, 1); PG8_STAGE(PG8_SB(1, 0), b3, voffB);
            PG8_BAR; PG8_WAIT_L(0); PG8_MMA(0, 1, At, B1); PG8_BAR;
            PG8_LDA(At, 1, 1); PG8_STAGE(PG8_SA(1, 0), a3, voffA);
            PG8_BAR; PG8_WAIT_L(0); PG8_MMA(1, 0, At, B0); PG8_BAR; PG8_SCHED;
            PG8_STAGE(PG8_SB(1, 1), b3 + hstep, voffB);
            PG8_WAIT_V(6); PG8_BAR; PG8_MMA(1, 1, At, B1); PG8_BAR;
        }
        E(acc, cur, wr, wc, fr, fq);
        if (!has_next) break;
#pragma unroll
        for (int a = 0; a < 2; ++a)
#pragma unroll
            for (int b = 0; b < 2; ++b)
#pragma unroll
                for (int m = 0; m < 4; ++m)
#pragma unroll
                    for (int n = 0; n < 2; ++n) acc[a][b][m][n] = (f32x4){0.f, 0.f, 0.f, 0.f};
        cur = nxt; cA = nA; cB = nB; ++ui;
    }
    PG8_WAIT_V(0);
    if (wr == 0) PG8_BAR;
    PG8_BAR;
#undef PG8_SA
#undef PG8_SB
#undef PG8_STAGE
#undef PG8_LDA
#undef PG8_LDB
#undef PG8_MMA
#undef PG8_WAIT_V
#undef PG8_WAIT_L
#undef PG8_BAR
#undef PG8_SCHED
}

__device__ __forceinline__ float silu_mul(float gt, float a) { return gt * a * __builtin_amdgcn_rcpf(1.f + __expf(-gt)); }
__device__ __forceinline__ float dpp_prev1(float prev, float cur) {
    const int o = __builtin_amdgcn_update_dpp(0, __builtin_bit_cast(int, prev), 0x10F, 0xf, 0xf, true);
    return __builtin_bit_cast(float, __builtin_amdgcn_update_dpp(o, __builtin_bit_cast(int, cur), 0x111, 0xf, 0xf, false)); }
__device__ __forceinline__ float dpp_prev2(float prev, float cur) {
    const int o = __builtin_amdgcn_update_dpp(0, __builtin_bit_cast(int, prev), 0x10E, 0xf, 0xf, true);
    return __builtin_bit_cast(float, __builtin_amdgcn_update_dpp(o, __builtin_bit_cast(int, cur), 0x112, 0xf, 0xf, false)); }
__device__ __forceinline__ size_t p_off(int row, int seg, int g) { return ((((size_t)(row >> 7) * 9 + seg) * 4 + g) * 128 + (row & 127)) * 256; }
struct EpiB {
    static constexpr bool PERM = true;
    int mode, l; bf16_t* O; int ldc; bf16_t* KB; bf16_t* VT; float* out; float* ST; bf16_t* Fo; float* HB; const float* cw; const float* cb;
    __device__ __forceinline__ void operator()(const f32x4 (&acc)[2][2][4][2], const Unit& u, int wr, int wc, int fr, int fq) const {
        const int row0 = u.pm * BM + wr * 64 + fr, col0 = u.pn * BM + wc * 32 + 8 * fq;
        if (mode == 0 && u.pm >= MT / BM) {
            const int rr0 = row0 - MT, cc0 = col0 - DIN;
            if (cc0 < 1024) {
                float* ko = out + O_MK + (size_t)l * (MMEM * D);
#pragma unroll
                for (int ai = 0; ai < 2; ++ai)
#pragma unroll
                    for (int m = 0; m < 4; ++m) { const int rr = rr0 + ai * HALF + m * 16;
#pragma unroll
                        for (int bj = 0; bj < 2; ++bj) { const f32x4 v0 = acc[ai][bj][m][0], v1 = acc[ai][bj][m][1]; const size_t o = (size_t)rr * D + cc0 + bj * HALF;
                            *(f32x4*)(ko + o) = v0; *(f32x4*)(ko + o + 4) = v1;
                            u32x4 w; w.x = cvt_pk_bf16(v0[0], v0[1]); w.y = cvt_pk_bf16(v0[2], v0[3]); w.z = cvt_pk_bf16(v1[0], v1[1]); w.w = cvt_pk_bf16(v1[2], v1[3]);
                            *(u32x4*)(KB + o) = w; } }
            } else {
                float* vo = out + O_MV + (size_t)l * (MMEM * D);
#pragma unroll
                for (int ai = 0; ai < 2; ++ai)
#pragma unroll
                    for (int m = 0; m < 4; ++m) { const int rr = rr0 + ai * HALF + m * 16; const int b = rr >> 8, mm = rr & 255;
#pragma unroll
                        for (int bj = 0; bj < 2; ++bj) { const f32x4 v0 = acc[ai][bj][m][0], v1 = acc[ai][bj][m][1]; const int c2 = cc0 - 1024 + bj * HALF;
                            const size_t o = (size_t)rr * D + c2;
                            *(f32x4*)(vo + o) = v0; *(f32x4*)(vo + o + 4) = v1;
                            bf16_t* vt = VT + ((size_t)(b * 4) * 256 + c2) * 256 + mm;
#pragma unroll
                            for (int j = 0; j < 4; ++j) { vt[(size_t)j * 256] = f2bf(v0[j]); vt[(size_t)(4 + j) * 256] = f2bf(v1[j]); } } }
            }
            return;
        }
        if (mode == 0 && u.pn >= 16 && u.pn < 20) {
#pragma unroll
            for (int ai = 0; ai < 2; ++ai)
#pragma unroll
                for (int m = 0; m < 4; ++m) { const f32x4 a0 = acc[ai][0][m][0], a1 = acc[ai][0][m][1], a2 = acc[ai][1][m][0], a3 = acc[ai][1][m][1];
                    const f32x4 sv = (a0 + a1) + (a2 + a3), qv = (a0 * a0 + a1 * a1) + (a2 * a2 + a3 * a3);
                    float ss = (sv[0] + sv[1]) + (sv[2] + sv[3]), qq = (qv[0] + qv[1]) + (qv[2] + qv[3]);
                    ss += __shfl_xor(ss, 16); qq += __shfl_xor(qq, 16); ss += __shfl_xor(ss, 32); qq += __shfl_xor(qq, 32);
                    if (fq == 0) { float* sp = ST + (((size_t)l * MT + row0 + ai * HALF + m * 16) * 16 + (u.pn - 16) * 4 + wc) * 2; sp[0] = ss; sp[1] = qq; } }
        }
        if (mode == 1) {
            const int ca = u.pn * 128 + wc * 32 + 8 * fq;
            if (u.pm >= MP / BM) {
#pragma unroll
                for (int ai = 0; ai < 2; ++ai)
#pragma unroll
                    for (int m = 0; m < 4; ++m) { const int row = row0 + ai * HALF + m * 16; const int q = row - MP, t = q & 3;
#pragma unroll
                        for (int bj = 0; bj < 2; ++bj) { const f32x4 v0 = acc[ai][bj][m][0], v1 = acc[ai][bj][m][1];
                            u32x4 w; w.x = cvt_pk_bf16(v0[0], v0[1]); w.y = cvt_pk_bf16(v0[2], v0[3]); w.z = cvt_pk_bf16(v1[0], v1[1]); w.w = cvt_pk_bf16(v1[2], v1[3]);
                            *(u32x4*)(O + (size_t)row * DFF2 + bj * DFF + ca) = w;
                            if (t >= 2) { float* dst = out + O_CFS + ((size_t)(l * NSEQ + (q >> 2)) * 2 + (t - 2)) * DFF2 + bj * DFF + ca; *(f32x4*)dst = v0; *(f32x4*)(dst + 4) = v1; } } }
                return;
            }
#pragma unroll
            for (int n = 0; n < 2; ++n) {
                const int cn = ca + 4 * n;
                const f32x4 wa0 = *(const f32x4*)(cw + cn), wa1 = *(const f32x4*)(cw + DFF2 + cn), wa2 = *(const f32x4*)(cw + 2 * DFF2 + cn), ba = *(const f32x4*)(cb + cn);
                const f32x4 wg0 = *(const f32x4*)(cw + DFF + cn), wg1 = *(const f32x4*)(cw + DFF2 + DFF + cn), wg2 = *(const f32x4*)(cw + 2 * DFF2 + DFF + cn), bg = *(const f32x4*)(cb + DFF + cn);
#pragma unroll
                for (int ai = 0; ai < 2; ++ai) {
                    const int grow = u.pm * BM + ai * HALF + wr * 64, gi = grow >> 6;
#pragma unroll
                    for (int m = 0; m < 4; ++m) {
                        const int row = grow + 16 * m + fr;
                        const f32x4 ca4 = acc[ai][0][m][n], cg4 = acc[ai][1][m][n], pa4 = acc[ai][0][m > 0 ? m - 1 : 0][n], pg4 = acc[ai][1][m > 0 ? m - 1 : 0][n];
                        f32x4 x1a, x2a, x1g, x2g;
#pragma unroll
                        for (int j = 0; j < 4; ++j) { x1a[j] = dpp_prev1(pa4[j], ca4[j]); x2a[j] = dpp_prev2(pa4[j], ca4[j]); x1g[j] = dpp_prev1(pg4[j], cg4[j]); x2g[j] = dpp_prev2(pg4[j], cg4[j]); }
                        const f32x4 fa = wa0 * x2a + wa1 * x1a + wa2 * ca4 + ba, fg = wg0 * x2g + wg1 * x1g + wg2 * cg4 + bg;
                        if (m > 0 || fr >= 2) { u32x2 w; w.x = cvt_pk_bf16(silu_mul(fg[0], fa[0]), silu_mul(fg[1], fa[1])); w.y = cvt_pk_bf16(silu_mul(fg[2], fa[2]), silu_mul(fg[3], fa[3]));
                            *(u32x2*)(Fo + (size_t)row * DFF + cn) = w; }
                        if ((m == 0 && fr < 2) || (m == 3 && fr >= 14)) {
                            float* hb = HB + ((size_t)gi * 4 + (m == 0 ? fr : fr - 12)) * DFF2 + cn;
                            *(f32x4*)hb = ca4; *(f32x4*)(hb + DFF) = cg4;
                            const int t = row & 2047;
                            if (t >= 2046) { float* dst = out + O_CFP + ((size_t)(l * 8 + (row >> 11)) * 2 + (t - 2046)) * DFF2 + cn; *(f32x4*)dst = ca4; *(f32x4*)(dst + DFF) = cg4; }
                        }
                    }
                }
            }
            return;
        }
#pragma unroll
        for (int ai = 0; ai < 2; ++ai)
#pragma unroll
            for (int m = 0; m < 4; ++m) { const int row = row0 + ai * HALF + m * 16; bf16_t* rowp = O + p_off(row, u.pn >> 2, u.pn & 3) + wc * 32 + 8 * fq;
#pragma unroll
                for (int bj = 0; bj < 2; ++bj) { const f32x4 v0 = acc[ai][bj][m][0], v1 = acc[ai][bj][m][1];
                    u32x4 w; w.x = cvt_pk_bf16(v0[0], v0[1]); w.y = cvt_pk_bf16(v0[2], v0[3]); w.z = cvt_pk_bf16(v1[0], v1[1]); w.w = cvt_pk_bf16(v1[2], v1[3]);
                    *(u32x4*)(rowp + bj * HALF) = w; } }
    }
};
struct EpiRes {
    static constexpr bool PERM = false;
    const float* src_p; const float* src_s; float* dst;
    __device__ __forceinline__ void operator()(const f32x4 (&acc)[2][2][4][2], const Unit& u, int wr, int wc, int fr, int fq) const {
        const int row0 = u.pm * BM + wr * 64 + fr, col0 = u.pn * BM + wc * 32 + 4 * fq;
        const float* sb = (u.pm < MP / BM) ? src_p : (src_s - (size_t)MP * D);
#pragma unroll
        for (int ai = 0; ai < 2; ++ai) {
            f32x4 rv[4][2][2];
#pragma unroll
            for (int m = 0; m < 4; ++m)
#pragma unroll
                for (int bj = 0; bj < 2; ++bj)
#pragma unroll
                    for (int n = 0; n < 2; ++n) rv[m][bj][n] = *(const f32x4*)(sb + (size_t)(row0 + ai * HALF + m * 16) * D + col0 + bj * HALF + n * 16);
            __builtin_amdgcn_sched_barrier(0);
#pragma unroll
            for (int m = 0; m < 4; ++m)
#pragma unroll
                for (int bj = 0; bj < 2; ++bj)
#pragma unroll
                    for (int n = 0; n < 2; ++n) *(f32x4*)(dst + (size_t)(row0 + ai * HALF + m * 16) * D + col0 + bj * HALF + n * 16) = rv[m][bj][n] + acc[ai][bj][m][n];
            __builtin_amdgcn_sched_barrier(0);
        }
    }
};

__device__ __forceinline__ void small_gemm_res(const bf16_t* A, const bf16_t* Bt, int K, const float* src, float* dst, int c, int tid, LAS unsigned char* lds) {
    const int w = __builtin_amdgcn_readfirstlane(tid >> 6), lane = tid & 63, fr = lane & 15, fq = lane >> 4;
    const int cg = w & 3, kh = w >> 2;
    const int row0 = 16 * (c & 31), col0 = 128 * (c >> 5) + 32 * cg, Kh = K >> 1;
    const bf16_t* ap = A + (size_t)(row0 + fr) * K + kh * Kh + 8 * fq;
    const bf16_t* bp = Bt + (size_t)(col0 + fr) * K + kh * Kh + 8 * fq;
    const size_t b16 = (size_t)16 * K;
    f32x4 acc0 = {0.f, 0.f, 0.f, 0.f}, acc1 = acc0;
    struct T { bf16x8 a[4], b0[4], b1[4]; };
    auto ldt = [&](int k) -> T { T t;
#pragma unroll
        for (int i = 0; i < 4; ++i) { t.a[i] = *(const bf16x8*)(ap + k + 32 * i); t.b0[i] = *(const bf16x8*)(bp + k + 32 * i); t.b1[i] = *(const bf16x8*)(bp + b16 + k + 32 * i); }
        return t; };
    auto mma = [&](const T& t) {
#pragma unroll
        for (int i = 0; i < 4; ++i) { acc0 = __builtin_amdgcn_mfma_f32_16x16x32_bf16(t.b0[i], t.a[i], acc0, 0, 0, 0); acc1 = __builtin_amdgcn_mfma_f32_16x16x32_bf16(t.b1[i], t.a[i], acc1, 0, 0, 0); } };
    T t0 = ldt(0);
#pragma unroll 1
    for (int k = 0; k < Kh; k += 256) {
        const bool h1 = k + 128 < Kh, h2 = k + 256 < Kh;
        T t1 = t0;
        if (h1) t1 = ldt(k + 128);
        mma(t0);
        if (h2) t0 = ldt(k + 256);
        if (h1) mma(t1);
    }
    LAS f32x4* ex = (LAS f32x4*)lds + (cg * 64 + lane) * 2;
    if (kh == 1) { ex[0] = acc0; ex[1] = acc1; }
    __syncthreads();
    if (kh == 0) {
        acc0 += ex[0]; acc1 += ex[1];
        const size_t o = (size_t)(row0 + fr) * D + col0 + 4 * fq;
        *(f32x4*)(dst + o) = *(const f32x4*)(src + o) + acc0;
        *(f32x4*)(dst + o + 16) = *(const f32x4*)(src + o + 16) + acc1;
    }
    __syncthreads();
}

__device__ __forceinline__ void transpose_item(const float* W, int K, int N, bf16_t* WT, LAS float* scr, int item, int lane, bool ffn_perm = false) {
    const int nblk = N / 32, kb = item / nblk, nb = item % nblk, k0 = 64 * kb, n0 = 32 * nb;
    const int d0 = !ffn_perm ? n0 : (n0 < DFF ? (n0 >> 7) * 256 + (n0 & 127) : ((n0 - DFF) >> 7) * 256 + 128 + ((n0 - DFF) & 127));
    {
        const int kr = lane >> 3, n4 = lane & 7;
        f32x4 v[8];
#pragma unroll
        for (int i = 0; i < 8; ++i) v[i] = __builtin_nontemporal_load((const f32x4*)(W + (size_t)(k0 + 8 * i + kr) * N + n0 + 4 * n4));
#pragma unroll
        for (int i = 0; i < 8; ++i) { LAS float* d = scr + (8 * i + kr) * 33 + 4 * n4; d[0] = v[i][0]; d[1] = v[i][1]; d[2] = v[i][2]; d[3] = v[i][3]; }
    }
    lds_wait();
    const int c = lane & 7;
#pragma unroll
    for (int j = 0; j < 4; ++j) { const int n = (lane >> 3) + 8 * j; const LAS float* s = scr + (8 * c) * 33 + n;
        u32x4 o; o.x = cvt_pk_bf16(s[0 * 33], s[1 * 33]); o.y = cvt_pk_bf16(s[2 * 33], s[3 * 33]); o.z = cvt_pk_bf16(s[4 * 33], s[5 * 33]); o.w = cvt_pk_bf16(s[6 * 33], s[7 * 33]);
        *(u32x4*)(WT + (size_t)(d0 + n) * K + k0 + 8 * c) = o; }
    lds_wait();
}
template <bool BF>
__device__ __forceinline__ void norm_rows(const float* src, const float* gain, void* dstv, int nrows, int gw, int ngw, int lane) {
    f32x4 gg[4];
#pragma unroll
    for (int j = 0; j < 4; ++j) gg[j] = ((const f32x4*)gain)[lane + 64 * j];
    for (int r = 4 * gw; r < nrows; r += 4 * ngw) {
        f32x4 v[4][4]; float sq[4];
#pragma unroll
        for (int i = 0; i < 4; ++i) { const f32x4* xr = (const f32x4*)(src + (size_t)(r + i) * D) + lane;
#pragma unroll
            for (int j = 0; j < 4; ++j) v[i][j] = xr[64 * j]; }
#pragma unroll
        for (int i = 0; i < 4; ++i) { float t = 0.f;
#pragma unroll
            for (int j = 0; j < 4; ++j) t += (v[i][j][0] * v[i][j][0] + v[i][j][1] * v[i][j][1]) + (v[i][j][2] * v[i][j][2] + v[i][j][3] * v[i][j][3]);
            sq[i] = t; }
#pragma unroll
        for (int o = 1; o < 64; o <<= 1) {
#pragma unroll
            for (int i = 0; i < 4; ++i) sq[i] += __shfl_xor(sq[i], o); }
#pragma unroll
        for (int i = 0; i < 4; ++i) { const float rstd = __builtin_amdgcn_rsqf(sq[i] * (1.f / D) + 1e-6f);
#pragma unroll
            for (int j = 0; j < 4; ++j) { const f32x4 y = v[i][j] * rstd * gg[j];
                if (BF) ((u32x2*)((bf16_t*)dstv + (size_t)(r + i) * D))[lane + 64 * j] = pack4(y); else ((f32x4*)((float*)dstv + (size_t)(r + i) * D))[lane + 64 * j] = y; } }
    }
}
struct F8 { f32x4 a, b; };
__device__ __forceinline__ F8 ld8_bf(const bf16_t* q) { const u32x4 a = *(const u32x4*)q; F8 o; o.a = (f32x4){bf_lo(a.x), bf_hi(a.x), bf_lo(a.y), bf_hi(a.y)}; o.b = (f32x4){bf_lo(a.z), bf_hi(a.z), bf_lo(a.w), bf_hi(a.w)}; return o; }
__device__ __forceinline__ F8 ld8_f(const float* q) { F8 o; o.a = *(const f32x4*)q; o.b = *(const f32x4*)(q + 4); return o; }
__device__ __forceinline__ void v_stats(const bf16_t* vp, int lane, float& mu, float& rstd) {
    const u32x4 a = *(const u32x4*)(vp + 8 * lane), b = *(const u32x4*)(vp + 512 + 8 * lane);
    const f32x4 x0 = {bf_lo(a.x), bf_hi(a.x), bf_lo(a.y), bf_hi(a.y)}, x1 = {bf_lo(a.z), bf_hi(a.z), bf_lo(a.w), bf_hi(a.w)};
    const f32x4 x2 = {bf_lo(b.x), bf_hi(b.x), bf_lo(b.y), bf_hi(b.y)}, x3 = {bf_lo(b.z), bf_hi(b.z), bf_lo(b.w), bf_hi(b.w)};
    const f32x4 sv = (x0 + x1) + (x2 + x3);
    mu = wave_sum((sv[0] + sv[1]) + (sv[2] + sv[3])) * (1.f / 1024.f);
    const f32x4 d0 = x0 - mu, d1 = x1 - mu, d2 = x2 - mu, d3 = x3 - mu;
    const f32x4 qv = (d0 * d0 + d1 * d1) + (d2 * d2 + d3 * d3);
    rstd = 1.f / sqrtf(wave_sum((qv[0] + qv[1]) + (qv[2] + qv[3])) * (1.f / 1024.f) + 1e-6f);
}

constexpr int VS = 136;
constexpr int KS = 528;
constexpr int KSK = 544;
template <int ROWS, bool SWZ = false, int STRIDE = 528>
__device__ __forceinline__ void stage_rows(const bf16_t* src, size_t gstride, LAS unsigned char* dst, int tid) {
    constexpr int N = ROWS * 32 / 512;
    u32x4 v[N];
#pragma unroll
    for (int i = 0; i < N; ++i) { const int idx = tid + 512 * i; v[i] = *(const u32x4*)(src + (size_t)(idx >> 5) * gstride + 8 * (idx & 31)); }
#pragma unroll
    for (int i = 0; i < N; ++i) { const int idx = tid + 512 * i, row = idx >> 5, cch = SWZ ? ((idx & 31) ^ (((row >> 4) & 3) << 2)) : (idx & 31);
        *(LAS u32x4*)(dst + row * STRIDE + 16 * cch) = v[i]; }
}
__device__ __forceinline__ void mixer_prompt(const Params& p, int l, int item, LAS unsigned char* lds, const int tid_in) {
    int tid = tid_in; asm volatile("" : "+v"(tid));
    const int w = __builtin_amdgcn_readfirstlane(tid >> 6), lane = tid & 63, fr = lane & 15, fq = lane >> 4;
    const int T = item >> 2, g = item & 3, r0 = T * 128, b = T >> 4, t0 = (T & 15) * 128;
    const bf16_t* P = (const bf16_t*)(p.ws + WS_P);
    LAS bf16_t* vnT = (LAS bf16_t*)lds;
    LAS float* stats = (LAS float*)(lds + 69632);
    LAS unsigned char* vts = lds + 71680;
    const int r = r0 + 16 * w + fr;
    bf16x8 pb[8];
    {
        bf16x8 qf[8];
#pragma unroll
        for (int k = 0; k < 8; ++k) qf[k] = *(const bf16x8*)(P + p_off(r, 5, g) + 32 * k + 8 * fq);
        stage_rows<256, false, KSK>((const bf16_t*)(p.ws + WS_KB) + (size_t)(b * 256) * D + 256 * g, D, lds, tid);
        __syncthreads();
        f32x4 sc[16];
        const LAS unsigned char* kp = lds + fr * KSK + 16 * fq;
        bf16x8 kfa[8], kfb[8];
#pragma unroll
        for (int k = 0; k < 8; ++k) kfa[k] = *(const LAS bf16x8*)(kp + 64 * k);
#pragma unroll
        for (int n = 0; n < 16; n += 2) {
#pragma unroll
            for (int k = 0; k < 8; ++k) kfb[k] = *(const LAS bf16x8*)(kp + (16 * (n + 1)) * KSK + 64 * k);
            __builtin_amdgcn_sched_barrier(0);
            { f32x4 a = {0.f, 0.f, 0.f, 0.f};
#pragma unroll
              for (int k = 0; k < 8; ++k) a = __builtin_amdgcn_mfma_f32_16x16x32_bf16(kfa[k], qf[k], a, 0, 0, 0);
              sc[n] = a; }
            __builtin_amdgcn_sched_barrier(0);
            if (n + 2 < 16) {
#pragma unroll
                for (int k = 0; k < 8; ++k) kfa[k] = *(const LAS bf16x8*)(kp + (16 * (n + 2)) * KSK + 64 * k); }
            __builtin_amdgcn_sched_barrier(0);
            { f32x4 a = {0.f, 0.f, 0.f, 0.f};
#pragma unroll
              for (int k = 0; k < 8; ++k) a = __builtin_amdgcn_mfma_f32_16x16x32_bf16(kfb[k], qf[k], a, 0, 0, 0);
              sc[n + 1] = a; }
            __builtin_amdgcn_sched_barrier(0);
        }
        float mx = -3.0e38f;
#pragma unroll
        for (int n = 0; n < 16; ++n) mx = fmaxf(fmaxf(mx, fmaxf(sc[n][0], sc[n][1])), fmaxf(sc[n][2], sc[n][3]));
        mx = fmaxf(mx, __shfl_xor(mx, 16)); mx = fmaxf(mx, __shfl_xor(mx, 32));
        float sum = 0.f;
#pragma unroll
        for (int n = 0; n < 16; ++n)
#pragma unroll
            for (int j = 0; j < 4; ++j) { const float e = __expf((sc[n][j] - mx) * 0.0625f); sc[n][j] = e; sum += e; }
        sum += __shfl_xor(sum, 16); sum += __shfl_xor(sum, 32);
        const float inv = 1.f / sum;
#pragma unroll
        for (int kk = 0; kk < 8; ++kk) pb[kk] = pack8(sc[2 * kk] * inv, sc[2 * kk + 1] * inv);
    }
    __syncthreads();
    if (tid < 128) { const f32x4* sp = (const f32x4*)((const float*)(p.ws + WS_ST) + ((size_t)l * MT + r0 + tid) * 32); f32x4 a4 = sp[0];
#pragma unroll
        for (int i = 1; i < 8; ++i) a4 += sp[i];
        const float mu = (a4[0] + a4[2]) * (1.f / 1024.f), var = fmaxf((a4[1] + a4[3]) * (1.f / 1024.f) - mu * mu, 0.f);
        stats[2 * tid] = mu; stats[2 * tid + 1] = 1.f / sqrtf(var + 1e-6f); }
    __syncthreads();
    const bf16_t* Vtg = (const bf16_t*)(p.ws + WS_VT) + ((size_t)(b * 4 + g) * 256) * 256;
    {
        const int s16 = lane & 15, j4 = lane >> 4;
        u32x4 raw[8];
        const int j = w * 4 + j4;
#pragma unroll
        for (int i = 0; i < 8; ++i) raw[i] = __builtin_nontemporal_load((const u32x4*)(P + p_off(r0 + 16 * i + s16, 4, g) + 8 * j));
        const float* lg = p.sg_ln_g + l * 1024 + 256 * g + 8 * j; const f32x4 g0 = *(const f32x4*)lg, g1 = *(const f32x4*)(lg + 4);
#pragma unroll
        for (int i = 0; i < 8; ++i) { const int s = 16 * i + s16;
            const float mu = stats[2 * s], rstd = stats[2 * s + 1];
            LAS bf16_t* d = vnT + (8 * j) * VS + s;
            d[0 * VS] = f2bf((bf_lo(raw[i].x) - mu) * rstd * g0[0]); d[1 * VS] = f2bf((bf_hi(raw[i].x) - mu) * rstd * g0[1]);
            d[2 * VS] = f2bf((bf_lo(raw[i].y) - mu) * rstd * g0[2]); d[3 * VS] = f2bf((bf_hi(raw[i].y) - mu) * rstd * g0[3]);
            d[4 * VS] = f2bf((bf_lo(raw[i].z) - mu) * rstd * g1[0]); d[5 * VS] = f2bf((bf_hi(raw[i].z) - mu) * rstd * g1[1]);
            d[6 * VS] = f2bf((bf_lo(raw[i].w) - mu) * rstd * g1[2]); d[7 * VS] = f2bf((bf_hi(raw[i].w) - mu) * rstd * g1[3]); }
        stage_rows<128, true>(Vtg, 256, vts, tid);
    }
    __syncthreads();
    const int tl = 16 * w + fr, kmax = w >> 1;
    bf16x8 wf[4];
    {
        const float* W = p.sg_w + ((size_t)(l * 4 + g) * 128 + tl) * 128 + 8 * fq;
        f32x4 wl0[4], wl1[4];
#pragma unroll
        for (int k = 0; k < 4; ++k) { wl0[k] = *(const f32x4*)(W + 32 * k); wl1[k] = *(const f32x4*)(W + 32 * k + 4); }
#pragma unroll
        for (int k = 0; k < 4; ++k) {
            f32x4 w0 = wl0[k], w1 = wl1[k];
            const int sb = 32 * k + 8 * fq;
#pragma unroll
            for (int i = 0; i < 4; ++i) { if (sb + i > tl) w0[i] = 0.f; if (sb + 4 + i > tl) w1[i] = 0.f; }
            wf[k] = pack8(w0, w1);
        }
    }
    {
        const float bs = p.sg_b[(l * 4 + g) * 128 + tl];
        const int tb = t0 + tl;
        const float* cw = p.conv_a_w + l * 3 * 1024 + 256 * g + 16 * fq;
        bf16_t* Y = (bf16_t*)(p.ws + WS_Y) + (size_t)r * D + 256 * g + 16 * fq;
        const bf16_t* pc = P + p_off(r, 0, g) + 16 * fq;
        const bf16_t* pcp = P + p_off(r >= 16 ? r - 16 : r, 0, g) + 16 * fq;
        constexpr size_t SEGS = (size_t)4 * 128 * 256;
        float* st = p.out + O_CAP + ((size_t)(l * 8 + b) * 2 + (tb - 2046)) * 1024 + 256 * g + 16 * fq;
        const f32x4 z4 = {0.f, 0.f, 0.f, 0.f};
        const bool ldprev = (fr >= 14) && (tb >= 16);
        struct S5 { u32x4 gm, gb, ga, u, bb, h2, c2, hp, cp; };
        auto load5 = [&](int sidx) -> S5 { const int co = 64 * (sidx >> 1) + 8 * (sidx & 1); S5 q;
            q.gm = *(const u32x4*)(pc + 8 * SEGS + co); q.gb = *(const u32x4*)(pc + 7 * SEGS + co); q.ga = *(const u32x4*)(pc + 6 * SEGS + co); q.u = *(const u32x4*)(pc + 3 * SEGS + co); q.bb = *(const u32x4*)(pc + 2 * SEGS + co);
            q.h2 = *(const u32x4*)(pc + co); q.c2 = *(const u32x4*)(pc + SEGS + co);
            const u32x4 zz = {0u, 0u, 0u, 0u};
            if (ldprev) { q.hp = *(const u32x4*)(pcp + co); q.cp = *(const u32x4*)(pcp + SEGS + co); } else { q.hp = zz; q.cp = zz; }
            return q; };
        auto up8 = [](const u32x4& a) -> F8 { F8 o; o.a = (f32x4){bf_lo(a.x), bf_hi(a.x), bf_lo(a.y), bf_hi(a.y)}; o.b = (f32x4){bf_lo(a.z), bf_hi(a.z), bf_lo(a.w), bf_hi(a.w)}; return o; };
        auto step5 = [&](const S5& q, int co, const f32x4& oa, const f32x4& ob, const f32x4& sga, const f32x4& sgb) {
            const F8 w0 = ld8_f(cw + co), w1 = ld8_f(cw + 1024 + co), w2 = ld8_f(cw + 2048 + co);
            const F8 h2 = up8(q.h2), c2 = up8(q.c2), hp = up8(q.hp), cp = up8(q.cp);
            const f32x4 ch2a = c2.a * h2.a, ch2b = c2.b * h2.b, chpa = cp.a * hp.a, chpb = cp.b * hp.b;
            f32x4 ch1a, ch1b, ch0a, ch0b;
#pragma unroll
            for (int j = 0; j < 4; ++j) { ch1a[j] = dpp_prev1(chpa[j], ch2a[j]); ch0a[j] = dpp_prev2(chpa[j], ch2a[j]); ch1b[j] = dpp_prev1(chpb[j], ch2b[j]); ch0b[j] = dpp_prev2(chpb[j], ch2b[j]); }
            const F8 bb = up8(q.bb);
            const f32x4 yaa = bb.a * (w0.a * ch0a + w1.a * ch1a + w2.a * ch2a), yab = bb.b * (w0.b * ch0b + w1.b * ch1b + w2.b * ch2b);
            const F8 gm = up8(q.gm), gb = up8(q.gb), ga = up8(q.ga), u = up8(q.u);
            f32x4 ya, yb;
#pragma unroll
            for (int j = 0; j < 4; ++j) { ya[j] = sigm(gm.a[j]) * oa[j] + sigm(gb.a[j]) * u.a[j] * (sga[j] + bs) + sigm(ga.a[j]) * yaa[j];
                yb[j] = sigm(gm.b[j]) * ob[j] + sigm(gb.b[j]) * u.b[j] * (sgb[j] + bs) + sigm(ga.b[j]) * yab[j]; }
            if (tb >= 2046) { *(f32x4*)(st + co) = ch2a; *(f32x4*)(st + co + 4) = ch2b; }
            u32x4 wv; wv.x = cvt_pk_bf16(ya[0], ya[1]); wv.y = cvt_pk_bf16(ya[2], ya[3]); wv.z = cvt_pk_bf16(yb[0], yb[1]); wv.w = cvt_pk_bf16(yb[2], yb[3]);
            *(u32x4*)(Y + co) = wv; };
        S5 cur = load5(0);
#pragma unroll 1
        for (int A = 0; A < 4; ++A) {
            if (A == 2) { __syncthreads(); stage_rows<128, true>(Vtg + 128 * 256, 256, vts, tid); __syncthreads(); }
            const int dbase = 64 * A + 16 * (fr >> 2) + (fr & 3);
            const S5 n1 = load5(2 * A + 1);
#pragma unroll
            for (int hlf = 0; hlf < 2; ++hlf) {
                f32x4 o[2], sa[2];
#pragma unroll
                for (int e = 0; e < 2; ++e) { f32x4 acc = z4; const LAS unsigned char* vrow = vts + ((dbase & 127) + 4 * (2 * hlf + e)) * KS + 8 * fq;
                    u32x4 vv[8];
#pragma unroll
                    for (int kk = 0; kk < 8; ++kk) { const int ko = 64 * (kk ^ (fr >> 2)); const u32x2 lo = *(const LAS u32x2*)(vrow + ko), hi = *(const LAS u32x2*)(vrow + ko + 32); vv[kk] = (u32x4){lo.x, lo.y, hi.x, hi.y}; }
                    __builtin_amdgcn_sched_barrier(0);
#pragma unroll
                    for (int kk = 0; kk < 8; ++kk) acc = __builtin_amdgcn_mfma_f32_16x16x32_bf16(__builtin_bit_cast(bf16x8, vv[kk]), pb[kk], acc, 0, 0, 0);
                    __builtin_amdgcn_sched_barrier(0);
                    o[e] = acc; }
#pragma unroll
                for (int e = 0; e < 2; ++e) { f32x4 acc = z4;
#pragma unroll
                    for (int k = 0; k < 4; ++k) if (k <= kmax) { const bf16x8 vf = *(const LAS bf16x8*)(vnT + (dbase + 4 * (2 * hlf + e)) * VS + 32 * k + 8 * fq); acc = __builtin_amdgcn_mfma_f32_16x16x32_bf16(vf, wf[k], acc, 0, 0, 0); }
                    sa[e] = acc; }
                if (hlf == 0) { step5(cur, 64 * A, o[0], o[1], sa[0], sa[1]); if (A < 3) cur = load5(2 * A + 2); }
                else step5(n1, 64 * A + 8, o[0], o[1], sa[0], sa[1]);
            }
        }
    }
    __syncthreads();
}

__device__ __forceinline__ void mixer_sample(const Params& p, int l, int item, LAS unsigned char* lds, const int tid_in) {
    int tid = tid_in; asm volatile("" : "+v"(tid));
    const int w = __builtin_amdgcn_readfirstlane(tid >> 6), lane = tid & 63, fr = lane & 15, fq = lane >> 4;
    const int s = item >> 2, g = item & 3, r0 = MP + 4 * s;
    const bf16_t* P = (const bf16_t*)(p.ws + WS_P);
    LAS float* st = (LAS float*)lds;
    LAS float* sc = (LAS float*)(lds + 1024);
    LAS float* pT = (LAS float*)(lds + 8192);
    LAS float* op = (LAS float*)(lds + 16384);
    if (tid < 4) { const f32x4* sp = (const f32x4*)((const float*)(p.ws + WS_ST) + ((size_t)l * MT + r0 + tid) * 32); f32x4 a4 = sp[0];
#pragma unroll
        for (int i = 1; i < 8; ++i) a4 += sp[i];
        const float mu = (a4[0] + a4[2]) * (1.f / 1024.f), var = fmaxf((a4[1] + a4[3]) * (1.f / 1024.f) - mu * mu, 0.f);
        st[2 * tid] = mu; st[2 * tid + 1] = 1.f / sqrtf(var + 1e-6f); }
    const size_t cbase = (((size_t)l * NSEQ + s) * 256 * 4 + g) * 256;
    {
        bf16x8 qf[8];
        const bf16_t* qp = P + p_off(r0 + (fr & 3), 5, g) + 8 * fq;
#pragma unroll
        for (int k = 0; k < 8; ++k) { qf[k] = *(const bf16x8*)(qp + 32 * k); if (fr >= 4) qf[k] = (bf16x8){0, 0, 0, 0, 0, 0, 0, 0}; }
        const float* Kc = p.cache_mem_k + cbase + (size_t)(32 * w + fr) * 1024 + 8 * fq;
        f32x4 kx[2][8][2];
#pragma unroll
        for (int nb = 0; nb < 2; ++nb)
#pragma unroll
            for (int k = 0; k < 8; ++k) { const float* kp = Kc + (size_t)(16 * nb) * 1024 + 32 * k;
                kx[nb][k][0] = __builtin_nontemporal_load((const f32x4*)kp); kx[nb][k][1] = __builtin_nontemporal_load((const f32x4*)(kp + 4)); }
        __builtin_amdgcn_sched_barrier(0);
#pragma unroll
        for (int nb = 0; nb < 2; ++nb) { f32x4 a = {0.f, 0.f, 0.f, 0.f};
#pragma unroll
            for (int k = 0; k < 8; ++k) a = __builtin_amdgcn_mfma_f32_16x16x32_bf16(pack8(kx[nb][k][0], kx[nb][k][1]), qf[k], a, 0, 0, 0);
            if (fr < 4) {
#pragma unroll
                for (int j = 0; j < 4; ++j) sc[fr * 256 + 32 * w + 16 * nb + 4 * fq + j] = a[j] * 0.0625f; } }
    }
    f32x4 vr[32];
    {
        const float* Vc = p.cache_mem_v + cbase + (size_t)(32 * w) * 1024 + 4 * lane;
#pragma unroll
        for (int mm = 0; mm < 32; ++mm) vr[mm] = __builtin_nontemporal_load((const f32x4*)(Vc + (size_t)mm * 1024));
    }
    __syncthreads();
    if (w < 4) {
        const f32x4 v = *(const LAS f32x4*)(sc + w * 256 + 4 * lane);
        const float mx = wave_max(fmaxf(fmaxf(v[0], v[1]), fmaxf(v[2], v[3])));
        f32x4 e = {__expf(v[0] - mx), __expf(v[1] - mx), __expf(v[2] - mx), __expf(v[3] - mx)};
        const float inv = 1.f / wave_sum((e[0] + e[1]) + (e[2] + e[3]));
#pragma unroll
        for (int i = 0; i < 4; ++i) pT[(4 * lane + i) * 4 + w] = e[i] * inv;
    }
    __syncthreads();
    {
        f32x4 o0 = {0.f, 0.f, 0.f, 0.f}, o1 = o0, o2 = o0, o3 = o0;
#pragma unroll
        for (int mm = 0; mm < 32; ++mm) { const f32x4 v = vr[mm]; const f32x4 pp = *(const LAS f32x4*)(pT + 4 * (32 * w + mm));
            o0 += pp[0] * v; o1 += pp[1] * v; o2 += pp[2] * v; o3 += pp[3] * v; }
        *(LAS f32x4*)(op + (w * 4 + 0) * 256 + 4 * lane) = o0; *(LAS f32x4*)(op + (w * 4 + 1) * 256 + 4 * lane) = o1;
        *(LAS f32x4*)(op + (w * 4 + 2) * 256 + 4 * lane) = o2; *(LAS f32x4*)(op + (w * 4 + 3) * 256 + 4 * lane) = o3;
    }
    __syncthreads();
    if (tid < 256) {
        const int cc = 256 * g + tid;
        constexpr size_t SEGS = (size_t)4 * 128 * 256;
        bf16_t pv[4][8];
#pragma unroll
        for (int t = 0; t < 4; ++t) { const bf16_t* q = P + p_off(r0 + t, 0, g) + tid;
            pv[t][0] = q[0]; pv[t][1] = q[SEGS]; pv[t][2] = q[2 * SEGS]; pv[t][3] = q[3 * SEGS]; pv[t][4] = q[4 * SEGS]; pv[t][5] = q[6 * SEGS]; pv[t][6] = q[7 * SEGS]; pv[t][7] = q[8 * SEGS]; }
        const float lg = p.sg_ln_g[l * 1024 + cc];
        const float* Wg = p.sg_w + (size_t)(l * 4 + g) * 128 * 128; const float* bg = p.sg_b + (l * 4 + g) * 128;
        const float cw0 = p.conv_a_w[l * 3072 + cc], cw1 = p.conv_a_w[l * 3072 + 1024 + cc], cw2 = p.conv_a_w[l * 3072 + 2048 + cc];
        float x[6];
        x[0] = p.cache_conv_a[((size_t)(l * NSEQ + s) * 2 + 0) * 1024 + cc]; x[1] = p.cache_conv_a[((size_t)(l * NSEQ + s) * 2 + 1) * 1024 + cc];
        const f32x4 wr0 = *(const f32x4*)(Wg), wr1 = *(const f32x4*)(Wg + 128), wr2 = *(const f32x4*)(Wg + 256), wr3 = *(const f32x4*)(Wg + 384), bgv = *(const f32x4*)bg;
        __builtin_amdgcn_sched_barrier(0);
        float ym[4];
#pragma unroll
        for (int t = 0; t < 4; ++t) { float a = 0.f;
#pragma unroll
            for (int ww = 0; ww < 8; ++ww) a += op[(ww * 4 + t) * 256 + tid];
            ym[t] = a; }
        float vn[4];
#pragma unroll
        for (int t = 0; t < 4; ++t) { vn[t] = (bf2f(pv[t][4]) - st[2 * t]) * st[2 * t + 1] * lg; x[2 + t] = bf2f(pv[t][1]) * bf2f(pv[t][0]); }
        const float sg0 = bgv[0] + wr0[0] * vn[0];
        const float sg1 = bgv[1] + wr1[0] * vn[0] + wr1[1] * vn[1];
        const float sg2 = bgv[2] + wr2[0] * vn[0] + wr2[1] * vn[1] + wr2[2] * vn[2];
        const float sg3 = bgv[3] + wr3[0] * vn[0] + wr3[1] * vn[1] + wr3[2] * vn[2] + wr3[3] * vn[3];
        const float sgv[4] = {sg0, sg1, sg2, sg3};
        float yv[4];
#pragma unroll
        for (int t = 0; t < 4; ++t) {
            const float yb = bf2f(pv[t][3]) * sgv[t];
            const float ya = bf2f(pv[t][2]) * (cw0 * x[t] + cw1 * x[t + 1] + cw2 * x[t + 2]);
            yv[t] = sigm(bf2f(pv[t][5])) * ya + sigm(bf2f(pv[t][6])) * yb + sigm(bf2f(pv[t][7])) * ym[t];
        }
        bf16_t* Y = (bf16_t*)(p.ws + WS_Y) + (size_t)r0 * D + cc;
#pragma unroll
        for (int t = 0; t < 4; ++t) { p.out[O_SV + ((size_t)(l * NSEQ + s) * 4 + t) * 1024 + cc] = vn[t]; Y[(size_t)t * D] = f2bf(yv[t]); }
        p.out[O_CAS + ((size_t)(l * NSEQ + s) * 2 + 0) * 1024 + cc] = x[4]; p.out[O_CAS + ((size_t)(l * NSEQ + s) * 2 + 1) * 1024 + cc] = x[5];
    }
    __syncthreads();
}

__device__ __forceinline__ F8 fma3(const F8& w0, const F8& x0, const F8& w1, const F8& x1, const F8& w2, const F8& x2, const F8& bb) {
    F8 o; o.a = w0.a * x0.a + w1.a * x1.a + w2.a * x2.a + bb.a; o.b = w0.b * x0.b + w1.b * x1.b + w2.b * x2.b + bb.b; return o; }
__device__ __forceinline__ void ffn_store(bf16_t* dst, const F8& av, const F8& gv) {
    u32x4 o;
    o.x = cvt_pk_bf16(silu_mul(gv.a[0], av.a[0]), silu_mul(gv.a[1], av.a[1])); o.y = cvt_pk_bf16(silu_mul(gv.a[2], av.a[2]), silu_mul(gv.a[3], av.a[3]));
    o.z = cvt_pk_bf16(silu_mul(gv.b[0], av.b[0]), silu_mul(gv.b[1], av.b[1])); o.w = cvt_pk_bf16(silu_mul(gv.b[2], av.b[2]), silu_mul(gv.b[3], av.b[3]));
    *(u32x4*)dst = o; }
__device__ __forceinline__ void ffn_elem(const Params& p, int l, int gw, int ngw, int lane) {
    const bf16_t* H = (const bf16_t*)(p.ws + WS_H); bf16_t* F = (bf16_t*)(p.ws + WS_F); const float* HB = (const float*)(p.ws + WS_HB);
    const float* cw = p.conv_f_w + (size_t)l * 3 * DFF2; const float* cb = p.conv_f_b + (size_t)l * DFF2;
    const f32x4 z4 = {0.f, 0.f, 0.f, 0.f};
    constexpr int NCB = 6;
    for (int it = gw; it < 256 * NCB; it += ngw) {
        const int gi = it / NCB, j = (it % NCB) * 64 + lane;
        if (j >= 352) continue;
        const int col = 8 * j; const bool first = (gi & 31) == 0;
        const F8 wa0 = ld8_f(cw + col), wa1 = ld8_f(cw + DFF2 + col), wa2 = ld8_f(cw + 2 * DFF2 + col), ba = ld8_f(cb + col);
        const F8 wg0 = ld8_f(cw + DFF + col), wg1 = ld8_f(cw + DFF2 + DFF + col), wg2 = ld8_f(cw + 2 * DFF2 + DFF + col), bg = ld8_f(cb + DFF + col);
        const float* hb = HB + (size_t)gi * 4 * DFF2 + col;
        F8 a0, a1, g0, g1;
        if (!first) { a0 = ld8_f(hb - 2 * DFF2); g0 = ld8_f(hb - 2 * DFF2 + DFF); a1 = ld8_f(hb - DFF2); g1 = ld8_f(hb - DFF2 + DFF); }
        else { a0.a = z4; a0.b = z4; a1 = a0; g0 = a0; g1 = a0; }
        const F8 xa0 = ld8_f(hb), xg0 = ld8_f(hb + DFF), xa1 = ld8_f(hb + DFF2), xg1 = ld8_f(hb + DFF2 + DFF);
        bf16_t* fp = F + (size_t)(64 * gi) * DFF + col;
        ffn_store(fp, fma3(wa0, a0, wa1, a1, wa2, xa0, ba), fma3(wg0, g0, wg1, g1, wg2, xg0, bg));
        ffn_store(fp + DFF, fma3(wa0, a1, wa1, xa0, wa2, xa1, ba), fma3(wg0, g1, wg1, xg0, wg2, xg1, bg));
    }
    for (int it = gw; it < NSEQ * NCB; it += ngw) {
        const int sq = it / NCB, j = (it % NCB) * 64 + lane;
        if (j >= 352) continue;
        const int col = 8 * j, rq = MP + 4 * sq;
        const F8 wa0 = ld8_f(cw + col), wa1 = ld8_f(cw + DFF2 + col), wa2 = ld8_f(cw + 2 * DFF2 + col), ba = ld8_f(cb + col);
        const F8 wg0 = ld8_f(cw + DFF + col), wg1 = ld8_f(cw + DFF2 + DFF + col), wg2 = ld8_f(cw + 2 * DFF2 + DFF + col), bg = ld8_f(cb + DFF + col);
        const float* cc = p.cache_conv_ffn + ((size_t)(l * NSEQ + sq) * 2) * DFF2 + col;
        const F8 a0 = ld8_f(cc), g0 = ld8_f(cc + DFF), a1 = ld8_f(cc + DFF2), g1 = ld8_f(cc + DFF2 + DFF);
        const bf16_t* hp = H + (size_t)rq * DFF2 + col;
        const F8 xa0 = ld8_bf(hp), xg0 = ld8_bf(hp + DFF), xa1 = ld8_bf(hp + DFF2), xg1 = ld8_bf(hp + DFF2 + DFF);
        const F8 xa2 = ld8_bf(hp + 2 * DFF2), xg2 = ld8_bf(hp + 2 * DFF2 + DFF), xa3 = ld8_bf(hp + 3 * DFF2), xg3 = ld8_bf(hp + 3 * DFF2 + DFF);
        bf16_t* fp = F + (size_t)rq * DFF + col;
        ffn_store(fp, fma3(wa0, a0, wa1, a1, wa2, xa0, ba), fma3(wg0, g0, wg1, g1, wg2, xg0, bg));
        ffn_store(fp + DFF, fma3(wa0, a1, wa1, xa0, wa2, xa1, ba), fma3(wg0, g1, wg1, xg0, wg2, xg1, bg));
        ffn_store(fp + 2 * DFF, fma3(wa0, xa0, wa1, xa1, wa2, xa2, ba), fma3(wg0, xg0, wg1, xg1, wg2, xg2, bg));
        ffn_store(fp + 3 * DFF, fma3(wa0, xa1, wa1, xa2, wa2, xa3, ba), fma3(wg0, xg1, wg1, xg2, wg2, xg3, bg));
    }
}

__device__ __forceinline__ int lane_id() { unsigned z = 0u; asm volatile("" : "+v"(z)); return (int)__builtin_amdgcn_mbcnt_hi(~0u, __builtin_amdgcn_mbcnt_lo(~0u, z)); }
#define XB_TMO      128
#define XB_XCNT(j)  (256  + 64 * (j))
#define XB_XSUB(j)  (1280 + 64 * (j))
#define XB_XGEN(j)  (2304 + 64 * (j))
#define XB_TOP      3328
#define XB_TOPGEN   3392
#define XCD_BAR_WORDS 3456
#define XB_SPIN_CAP (1u << 18)
__device__ __forceinline__ unsigned xb_ld(unsigned* p)              { return __hip_atomic_load(p, __ATOMIC_RELAXED, __HIP_MEMORY_SCOPE_AGENT); }
__device__ __forceinline__ unsigned xb_add(unsigned* p, unsigned v) { return __hip_atomic_fetch_add(p, v, __ATOMIC_RELAXED, __HIP_MEMORY_SCOPE_AGENT); }
__device__ __forceinline__ unsigned xb_xcc_id() { return (unsigned)__builtin_amdgcn_s_getreg((3 << 11) | 20) & 0xFu; }
#define XB_SPIN(cond, bar) do { unsigned _sp = 0; while (cond) { __builtin_amdgcn_s_sleep(1); \
    if ((++_sp & 255u) == 0u) { if (xb_ld(&(bar)[XB_TMO])) break; if (_sp > XB_SPIN_CAP) { atomicAdd(&(bar)[XB_TMO], 1u); break; } } } } while (0)
struct XcdBarrier { unsigned* bar; unsigned x; volatile LAS unsigned* st; };
__device__ __forceinline__ XcdBarrier xcd_barrier_post(unsigned* bar, volatile LAS unsigned* st, bool leader) {
    XcdBarrier b; b.bar = bar; b.x = xb_xcc_id(); b.st = st;
    if (leader) (void)xb_add(&bar[XB_XCNT(b.x)], 1u);
    return b;
}
__device__ __forceinline__ void xcd_barrier_complete(unsigned* bar, unsigned x, unsigned& nloc, unsigned& nx) {
    const unsigned G = gridDim.x * gridDim.y * gridDim.z;
    unsigned sum, cnt, mine, sp = 0u;
    for (;;) {
        sum = 0u; cnt = 0u; mine = 0u;
#pragma unroll
        for (unsigned j = 0; j < 16; ++j) { const unsigned c = xb_ld(&bar[XB_XCNT(j)]); sum += c; cnt += (c > 0u) ? 1u : 0u; mine = (j == x) ? c : mine; }
        if (sum == G) break;
        __builtin_amdgcn_s_sleep(1);
        if ((++sp & 255u) == 0u) { if (xb_ld(&bar[XB_TMO])) break; if (sp > XB_SPIN_CAP) { atomicAdd(&bar[XB_TMO], 1u); break; } }
    }
    nloc = mine > 0u ? mine : 1u; nx = cnt > 0u ? cnt : 1u;
}
__device__ __forceinline__ void xcd_barrier(const XcdBarrier& b, const int wave0) {
    asm volatile("s_waitcnt vmcnt(0)" ::: "memory");
    __syncthreads();
    if (wave0 == 0 && lane_id() == 0) {
        unsigned* bar = b.bar; asm volatile("" : "+s"(bar));
        unsigned bx = b.x; asm volatile("" : "+s"(bx));
        __builtin_amdgcn_s_waitcnt(0);
        unsigned nloc = b.st[0], nx = b.st[1];
        if (nloc == 0u) { xcd_barrier_complete(bar, bx, nloc, nx); b.st[0] = nloc; b.st[1] = nx; }
        const unsigned old = xb_add(&bar[XB_XSUB(bx)], 1u);
        const unsigned gen = old / nloc;
        if (old + 1u == (gen + 1u) * nloc) {
            __builtin_amdgcn_fence(__ATOMIC_RELEASE, "agent");
            asm volatile("s_waitcnt vmcnt(0)" ::: "memory");
            const unsigned og = xb_add(&bar[XB_TOP], 1u);
            const unsigned tg = og / nx;
            if (og + 1u == (tg + 1u) * nx) xb_add(&bar[XB_TOPGEN], 1u);
            else XB_SPIN(xb_ld(&bar[XB_TOPGEN]) == tg, bar);
            __builtin_amdgcn_fence(__ATOMIC_ACQUIRE, "agent");
            xb_add(&bar[XB_XGEN(bx)], 1u);
            asm volatile("s_waitcnt vmcnt(0)" ::: "memory");
        } else {
            XB_SPIN(xb_ld(&bar[XB_XGEN(bx)]) == gen, bar);
            __builtin_amdgcn_fence(__ATOMIC_ACQUIRE, "agent");
            asm volatile("s_waitcnt vmcnt(0)" ::: "memory");
        }
    }
    __syncthreads();
}

__global__ void __launch_bounds__(512, 2) fwd_megakernel(Params p) {
    extern __shared__ __attribute__((aligned(16))) unsigned char shm[];
    LAS unsigned char* lds = (LAS unsigned char*)shm;
    cg::grid_group grid = cg::this_grid();
    volatile LAS unsigned* xb_st = (volatile LAS unsigned*)(lds + LDS_BYTES - 16);
    const int wave0 = __builtin_amdgcn_readfirstlane((int)threadIdx.x >> 6);
    const bool leader0 = (wave0 == 0) && (lane_id() == 0);
    if (leader0) { xb_st[0] = 0u; xb_st[1] = 0u; }
    __syncthreads();
    const XcdBarrier xb = xcd_barrier_post((unsigned*)(p.ws + WS_BAR), xb_st, leader0);
    const int G = gridDim.x, c = blockIdx.x, ngw = G * 8;
    bf16_t* WT = (bf16_t*)(p.ws + WS_WT);
    bf16_t* ZA = (bf16_t*)(p.ws + WS_ZA);
    float* X = (float*)(p.ws + WS_X);

#pragma unroll 1
    for (int rep0 = 0; rep0 < (((DUP_MASK >> 8) & 1) ? 2 : 1); ++rep0) {
        const int lane = lane_id(), wave = wave0, tid = wave0 * 64 + lane, gw = c * 8 + wave;
        LAS float* scr = (LAS float*)(lds + wave * 8448);
        constexpr int I_IN = 16 * (DIN / 32), I_K = 16 * 32, I_O = 16 * 32, I_UP = 16 * (DFF2 / 32), I_DN = (DFF / 64) * 32, I_L = I_IN + 2 * I_K + I_O + I_UP + I_DN;
        for (int it = gw; it < 2 * I_L; it += ngw) {
            const int l = it / I_L; int r = it % I_L; bf16_t* wl = WT + (size_t)l * WL_SZ;
            if (r < I_IN) { transpose_item(p.w_in + (size_t)l * D * DIN, D, DIN, wl + WL_IN, scr, r, lane); continue; } r -= I_IN;
            if (r < I_K) { transpose_item(p.w_k + (size_t)l * D * D, D, D, wl + WL_KV, scr, r, lane); continue; } r -= I_K;
            if (r < I_K) { transpose_item(p.w_v + (size_t)l * D * D, D, D, wl + WL_KV + (size_t)D * D, scr, r, lane); continue; } r -= I_K;
            if (r < I_O) { transpose_item(p.w_o + (size_t)l * D * D, D, D, wl + WL_O, scr, r, lane); continue; } r -= I_O;
            if (r < I_UP) { transpose_item(p.w_up + (size_t)l * D * DFF2, D, DFF2, wl + WL_UP, scr, r, lane, true); continue; } r -= I_UP;
            transpose_item(p.w_down + (size_t)l * DFF * D, DFF, D, wl + WL_DN, scr, r, lane);
        }
        norm_rows<true>(p.x_prompt, p.norm_mix_g, ZA, MP, gw, ngw, lane);
        norm_rows<true>(p.x_sample, p.norm_mix_g, ZA + (size_t)MP * D, MS, gw, ngw, lane);
        norm_rows<true>(p.mem_prompt, p.norm_mem_g, ZA + (size_t)MT * D, MMEM, gw, ngw, lane);
    }
    if (p.ws == nullptr) grid.sync();
    xcd_barrier(xb, wave0);

#pragma unroll 1
    for (int ph = 0; ph < 16; ++ph) {
        const int l = ph >> 3, sub = ph & 7;
        const bf16_t* wl = WT + (size_t)l * WL_SZ;
        const int nrep = ((DUP_MASK >> sub) & 1) ? 2 : 1;
#pragma unroll 1
        for (int rep = 0; rep < nrep; ++rep) {
        if (rep) xcd_barrier(xb, wave0);
        int lane = lane_id(); asm volatile("" : "+v"(lane));
        const int wave = wave0, tid = wave0 * 64 + lane, gw = c * 8 + wave;
        if (sub == 0 || sub == 4) {
            Gemm g; Sched S; EpiB E;
            S.G = G; S.c = c; S.nM = MT / BM; E.l = l; E.KB = (bf16_t*)(p.ws + WS_KB); E.VT = (bf16_t*)(p.ws + WS_VT); E.out = p.out; E.ST = (float*)(p.ws + WS_ST); E.Fo = (bf16_t*)(p.ws + WS_F); E.HB = (float*)(p.ws + WS_HB); E.cw = p.conv_f_w + (size_t)l * 3 * DFF2; E.cb = p.conv_f_b + (size_t)l * DFF2; g.K = D; g.A = ZA;
            if (sub == 0) { g.Bt = wl + WL_IN; S.nN = DIN / BM; S.extra = 64; S.xpm0 = MT / BM; S.xpn0 = DIN / BM; E.mode = 0; E.O = (bf16_t*)(p.ws + WS_P); E.ldc = DIN; }
            else { g.Bt = wl + WL_UP; S.nN = DFF2 / BM; S.extra = 0; S.xpm0 = 0; S.xpn0 = 0; E.mode = 1; E.O = (bf16_t*)(p.ws + WS_H); E.ldc = DFF2; }
            S.nwg = S.nM * S.nN;
            gemm_phase<EpiB>(lds, tid, g, S, E);
        } else if (sub == 2 || sub == 6) {
            Gemm g; Sched S; EpiRes E;
            S.G = G; S.c = c; S.nM = MP / BM; S.nN = D / BM; S.nwg = S.nM * S.nN; S.extra = 0; S.xpm0 = 0; S.xpn0 = 0;
            E.dst = X; E.src_p = X; E.src_s = X + (size_t)MP * D;
            if (sub == 2) { g.A = (const bf16_t*)(p.ws + WS_Y); g.Bt = wl + WL_O; g.K = D; if (l == 0) { E.src_p = p.x_prompt; E.src_s = p.x_sample; } }
            else { g.A = (const bf16_t*)(p.ws + WS_F); g.Bt = wl + WL_DN; g.K = DFF; }
            if (nrep == 2 && rep == 0) E.dst = (float*)(p.ws + WS_H);
            gemm_phase<EpiRes>(lds, tid, g, S, E);
            for (int uu = c; uu < 256; uu += G) small_gemm_res(g.A + (size_t)MP * g.K, g.Bt, g.K, E.src_s, E.dst + (size_t)MP * D, uu, tid, lds);
        } else if (sub == 1) {
            for (int k = 0; k < 4; ++k) {
                const int kk = k ^ 2;
                const int item = c + (kk & 1) * G;
#ifdef DUP_MIX_MODE
                if (nrep == 2 && rep == 0 && ((kk < 2) != (DUP_MIX_MODE == 1))) continue;
#endif
                if (item < 512) { if (kk < 2) mixer_prompt(p, l, item, lds, tid); else mixer_sample(p, l, item, lds, tid); }
            }
            for (int item = c + 2 * G; item < 512; item += G) { mixer_prompt(p, l, item, lds, tid); mixer_sample(p, l, item, lds, tid); }
        } else if (sub == 3) {
            norm_rows<true>(X, p.norm_ffn_g + l * D, ZA, MT, gw, ngw, lane);
        } else if (sub == 5) {
            ffn_elem(p, l, gw, ngw, lane);
        } else {
            if (l == 0) { norm_rows<true>(X, p.norm_mix_g + D, ZA, MT, gw, ngw, lane); norm_rows<true>(p.mem_prompt, p.norm_mem_g + D, ZA + (size_t)MT * D, MMEM, gw, ngw, lane); }
            else norm_rows<false>(X, p.norm_final_g, p.out + O_YP, MT, gw, ngw, lane);
        }
        }
#ifdef EXTRA_SYNCS
        for (int es = 0; es < EXTRA_SYNCS; ++es) xcd_barrier(xb, wave0);
#endif
        if (ph < 15) xcd_barrier(xb, wave0);
    }
}

extern "C" void kernel_launch(void* const* d_in, const int* in_sizes, int n_in, void* d_out, int out_size, void* d_ws, size_t ws_size, hipStream_t stream) {
    static int grid_blocks = 0;
    if (grid_blocks == 0) {
        if (n_in != 23 || ws_size < WS_END) { fprintf(stderr, "kernel_launch: unexpected n_in %d or ws_size %zu (< %zu)\n", n_in, ws_size, (size_t)WS_END); grid_blocks = -1; return; }
        int dev = 0, cus = 0, per_cu = 0;
        hipGetDevice(&dev);
        hipDeviceGetAttribute(&cus, hipDeviceAttributeMultiprocessorCount, dev);
        hipFuncSetAttribute((const void*)fwd_megakernel, hipFuncAttributeMaxDynamicSharedMemorySize, LDS_BYTES);
        hipOccupancyMaxActiveBlocksPerMultiprocessor(&per_cu, (const void*)fwd_megakernel, 512, LDS_BYTES);
        if (per_cu < 1) { fprintf(stderr, "kernel_launch: occupancy query reports %d blocks per CU\n", per_cu); grid_blocks = -1; return; }
        grid_blocks = cus;
    }
    if (grid_blocks < 0) return;
    if (hipMemsetAsync((char*)d_ws + WS_BAR, 0, 16384, stream) != hipSuccess) { fprintf(stderr, "kernel_launch: memset of the barrier words failed\n"); return; }
    Params p{};
    const float** pp = (const float**)&p;
    for (int i = 0; i < 23; ++i) pp[i] = (const float*)d_in[i];
    p.out = (float*)d_out; p.ws = (unsigned char*)d_ws;
    void* args[] = {&p};
    hipError_t e = hipLaunchCooperativeKernel((const void*)fwd_megakernel, dim3(grid_blocks), dim3(512), args, LDS_BYTES, stream);
    if (e != hipSuccess) fprintf(stderr, "cooperative launch failed: %s (grid %d)\n", hipGetErrorString(e), grid_blocks);
}
```

```cpp
#include <hip/hip_runtime.h>
#include <hip/hip_cooperative_groups.h>
#include <cstdio>
namespace cg = cooperative_groups;

#define LAS __attribute__((address_space(3)))
typedef unsigned short bf16_t;
typedef short bf16x8 __attribute__((ext_vector_type(8)));
typedef float f32x4 __attribute__((ext_vector_type(4)));
typedef unsigned u32x4 __attribute__((ext_vector_type(4)));
typedef unsigned u32x2 __attribute__((ext_vector_type(2)));

constexpr int D = 1024, MP = 16384, MS = 512, MT = MP + MS, MMEM = 2048, DIN = 9216, DFF = 2816, DFF2 = 5632;
constexpr int NSEQ = 128;
constexpr size_t O_YP = 0, O_CAP = 17301504, O_CFP = 17334272, O_MK = 17514496, O_MV = 21708800, O_CAS = 25903104, O_CFS = 26427392, O_SV = 29310976;
constexpr size_t WL_IN = 0, WL_KV = (size_t)DIN * D, WL_O = WL_KV + (size_t)2048 * D, WL_UP = WL_O + (size_t)D * D, WL_DN = WL_UP + (size_t)DFF2 * D, WL_SZ = WL_DN + (size_t)D * DFF;
constexpr size_t WS_WT = 0;
constexpr size_t WS_ZA = WS_WT + 2 * WL_SZ * 2;
constexpr size_t WS_Y = WS_ZA + (size_t)(MT + MMEM) * D * 2;
constexpr size_t WS_X = WS_Y + (size_t)MT * D * 2;
constexpr size_t WS_KB = WS_X + (size_t)MT * D * 4;
constexpr size_t WS_VT = WS_KB + (size_t)MMEM * D * 2;
constexpr size_t WS_P = WS_VT + (size_t)MMEM * D * 2;
constexpr size_t WS_H = WS_P;
constexpr size_t WS_F = WS_H + (size_t)MT * DFF2 * 2;
constexpr size_t WS_ST = WS_P + (size_t)MT * DIN * 2;
constexpr size_t WS_BAR = WS_ST + (size_t)2 * MT * 16 * 2 * 4;
constexpr size_t WS_HB = WS_BAR + 16384;
constexpr size_t WS_END = WS_HB + (size_t)256 * 4 * DFF2 * 4;
constexpr int LDS_BYTES = 160 * 1024;
#ifndef DUP_MASK
#define DUP_MASK 0
#endif

struct Params {
    const float *x_prompt, *x_sample, *mem_prompt, *cache_conv_a, *cache_conv_ffn, *cache_mem_k, *cache_mem_v, *norm_mix_g, *w_in, *conv_a_w, *sg_ln_g, *sg_w, *sg_b,
        *norm_mem_g, *w_k, *w_v, *w_o, *norm_ffn_g, *w_up, *conv_f_w, *conv_f_b, *w_down, *norm_final_g;
    float* out; unsigned char* ws;
};

__device__ __forceinline__ unsigned cvt_pk_bf16(float lo, float hi) { unsigned r; asm("v_cvt_pk_bf16_f32 %0, %1, %2" : "=v"(r) : "v"(lo), "v"(hi)); return r; }
__device__ __forceinline__ float bf_lo(unsigned u) { return __uint_as_float(u << 16); }
__device__ __forceinline__ float bf_hi(unsigned u) { return __uint_as_float(u & 0xffff0000u); }
__device__ __forceinline__ float bf2f(bf16_t b) { return __uint_as_float(((unsigned)b) << 16); }
__device__ __forceinline__ bf16_t f2bf(float f) { return (bf16_t)(cvt_pk_bf16(f, 0.f) & 0xffffu); }
__device__ __forceinline__ f32x4 unpack4(u32x2 u) { return (f32x4){bf_lo(u.x), bf_hi(u.x), bf_lo(u.y), bf_hi(u.y)}; }
__device__ __forceinline__ u32x2 pack4(f32x4 v) { u32x2 r; r.x = cvt_pk_bf16(v[0], v[1]); r.y = cvt_pk_bf16(v[2], v[3]); return r; }
__device__ __forceinline__ bf16x8 pack8(f32x4 a, f32x4 b) { u32x4 w; w.x = cvt_pk_bf16(a[0], a[1]); w.y = cvt_pk_bf16(a[2], a[3]); w.z = cvt_pk_bf16(b[0], b[1]); w.w = cvt_pk_bf16(b[2], b[3]); return __builtin_bit_cast(bf16x8, w); }
__device__ __forceinline__ float sigm(float x) { return __builtin_amdgcn_rcpf(1.f + __expf(-x)); }
__device__ __forceinline__ float wave_sum(float v) {
#pragma unroll
    for (int o = 1; o < 64; o <<= 1) v += __shfl_xor(v, o);
    return v;
}
__device__ __forceinline__ float wave_max(float v) {
#pragma unroll
    for (int o = 1; o < 64; o <<= 1) v = fmaxf(v, __shfl_xor(v, o));
    return v;
}
__device__ __forceinline__ void lds_wait() { asm volatile("s_waitcnt lgkmcnt(0)" ::: "memory"); }

constexpr int BM = 256, BK = 64, HALF = 128, HTB = HALF * BK * 2, NXCD = 8, WGM = 5;
__device__ __forceinline__ int lds_byte(int r, int c) { const int st = (r >> 4) * 2 + (c >> 5), rr = r & 15, cc = c & 31, ob = rr * 64 + cc * 2; return st * 1024 + (ob ^ (((ob >> 9) & 1) << 5)); }
__device__ __forceinline__ void stage_rc(int b, int& R, int& C) { const int st = b / 1024, sb = b % 1024, swz = sb ^ (((sb >> 9) & 1) << 5); R = (st >> 1) * 16 + swz / 64; C = (st & 1) * 32 + (swz % 64) / 2; }
__device__ __forceinline__ int perm32(int rho) { const int n = rho >> 4, i = rho & 15; return 8 * (i >> 2) + 4 * n + (i & 3); }
struct Unit { int pm, pn; };
struct Gemm { const bf16_t* A; const bf16_t* Bt; int K; };
struct Sched {
    int nM, nN, nwg, extra, xpm0, xpn0, G, c;
    __device__ __forceinline__ bool next(int i, Unit& u) const {
        const int L = i * G + c;
        if (L >= nwg + extra) return false;
        if (L >= nwg) { const int q = L - nwg; u.pm = xpm0 + (q >> 3); u.pn = xpn0 + (q & 7); return true; }
        int wgid = L; { const int q = nwg / NXCD, r = nwg % NXCD, xcd = wgid % NXCD, off = wgid / NXCD; wgid = (xcd < r ? xcd * (q + 1) : r * (q + 1) + (xcd - r) * q) + off; }
        const int nig = WGM * nN, gid = wgid / nig, fm = gid * WGM, gsz = (nM - fm) < WGM ? (nM - fm) : WGM;
        u.pm = fm + ((wgid % nig) % gsz); u.pn = (wgid % nig) / gsz; return true;
    }
};

template <class Epi, int KC = 0>
__device__ __forceinline__ void gemm_phase(LAS unsigned char* lds, const int tid, const Gemm g, const Sched& S, const Epi& E) {
    const int wid = __builtin_amdgcn_readfirstlane(tid >> 6), lane = tid & 63, wr = wid >> 2, wc = wid & 3, fr = lane & 15, fq = lane >> 4;
    const int K = KC ? KC : g.K, nt = K / BK;
    unsigned voffA[2], voffB[2];
#pragma unroll
    for (int i = 0; i < 2; ++i) { int R, C; stage_rc(tid * 16 + i * 8192, R, C); const int Rb = Epi::PERM ? ((R & ~31) + perm32(R & 31)) : R;
        voffA[i] = (unsigned)(R * K + C) * 2u; voffB[i] = (unsigned)(Rb * K + C) * 2u; }
    const size_t kstep = (size_t)(BK * 2);
    const size_t hstep = (size_t)HALF * K * 2;
    const size_t tstep = 2 * hstep;
    const unsigned ldsw = (unsigned)wid * 1024u;
    const int aoff = lds_byte(wr * 64 + fr, fq * 8), boff = lds_byte(wc * 32 + fr, fq * 8);
#define PG8_SA(b, h) (((b) * 2 + (h)) * HTB)
#define PG8_SB(b, h) ((4 + (b) * 2 + (h)) * HTB)
#define PG8_STAGE(bufoff, gbase, voff) do { _Pragma("unroll") for (int _i = 0; _i < 2; ++_i) \
        __builtin_amdgcn_global_load_lds((const unsigned*)((const char*)(gbase) + (voff)[_i]), (LAS unsigned*)(lds + (bufoff) + ldsw + _i * 8192), 16, 0, 0); } while (0)
#define PG8_LDA(dst, b, h) do { _Pragma("unroll") for (int m = 0; m < 4; ++m) _Pragma("unroll") for (int k = 0; k < 2; ++k) dst[m][k] = *(const LAS bf16x8*)(lds + PG8_SA(b, h) + aoff + m * 2048 + k * 1024); } while (0)
#define PG8_LDB(dst, b, h) do { _Pragma("unroll") for (int n = 0; n < 2; ++n) _Pragma("unroll") for (int k = 0; k < 2; ++k) dst[n][k] = *(const LAS bf16x8*)(lds + PG8_SB(b, h) + boff + n * 2048 + k * 1024); } while (0)
#define PG8_MMA(ai, bj, At, Bt) do { __builtin_amdgcn_s_setprio(1); _Pragma("unroll") for (int m = 0; m < 4; ++m) _Pragma("unroll") for (int n = 0; n < 2; ++n) _Pragma("unroll") for (int k = 0; k < 2; ++k) \
        acc[ai][bj][m][n] = __builtin_amdgcn_mfma_f32_16x16x32_bf16(Bt[n][k], At[m][k], acc[ai][bj][m][n], 0, 0, 0); __builtin_amdgcn_s_setprio(0); } while (0)
#define PG8_WAIT_V(n) asm volatile("s_waitcnt vmcnt(" #n ")" ::: "memory")
#define PG8_WAIT_L(n) asm volatile("s_waitcnt lgkmcnt(" #n ")" ::: "memory")
#define PG8_BAR __builtin_amdgcn_s_barrier()
#define PG8_SCHED __builtin_amdgcn_sched_barrier(0)
    Unit cur, nxt; int ui = 0;
    if (!S.next(0, cur)) return;
    f32x4 acc[2][2][4][2];
#pragma unroll
    for (int a = 0; a < 2; ++a)
#pragma unroll
        for (int b = 0; b < 2; ++b)
#pragma unroll
            for (int m = 0; m < 4; ++m)
#pragma unroll
                for (int n = 0; n < 2; ++n) acc[a][b][m][n] = (f32x4){0.f, 0.f, 0.f, 0.f};
    bf16x8 At[4][2], B0[2][2], B1[2][2];
    const char* cA = (const char*)g.A + (size_t)cur.pm * tstep; const char* cB = (const char*)g.Bt + (size_t)cur.pn * tstep;
    PG8_STAGE(PG8_SB(0, 0), cB, voffB); PG8_STAGE(PG8_SA(0, 0), cA, voffA); PG8_STAGE(PG8_SB(0, 1), cB + hstep, voffB); PG8_STAGE(PG8_SA(0, 1), cA + hstep, voffA);
    if (wr == 1) PG8_BAR;
    PG8_WAIT_V(4); PG8_BAR;
    PG8_STAGE(PG8_SB(1, 0), cB + kstep, voffB); PG8_STAGE(PG8_SA(1, 0), cA + kstep, voffA); PG8_STAGE(PG8_SB(1, 1), cB + hstep + kstep, voffB);
    PG8_WAIT_V(6); PG8_BAR;
    for (;;) {
        const bool has_next = S.next(ui + 1, nxt);
        const char* nA = has_next ? (const char*)g.A + (size_t)nxt.pm * tstep : cA; const char* nB = has_next ? (const char*)g.Bt + (size_t)nxt.pn * tstep : cB;
#pragma unroll 1
        for (int t = 0; t < nt; t += 2) {
            const bool last = (t == nt - 2);
            const char* a1 = cA + (size_t)(t + 1) * kstep;
            const char* a2 = last ? nA : cA + (size_t)(t + 2) * kstep; const char* b2 = last ? nB : cB + (size_t)(t + 2) * kstep;
            const char* a3 = a2 + kstep; const char* b3 = b2 + kstep;
            PG8_LDB(B0, 0, 0); PG8_SCHED; PG8_LDA(At, 0, 0); PG8_STAGE(PG8_SA(1, 1), a1 + hstep, voffA);
            PG8_WAIT_L(8); PG8_BAR; PG8_WAIT_L(0); PG8_MMA(0, 0, At, B0); PG8_BAR; PG8_SCHED;
            PG8_LDB(B1, 0, 1); PG8_STAGE(PG8_SB(0, 0), b2, voffB);
            PG8_BAR; PG8_WAIT_L(0); PG8_MMA(0, 1, At, B1); PG8_BAR;
            PG8_LDA(At, 0, 1); PG8_STAGE(PG8_SA(0, 0), a2, voffA);
            PG8_BAR; PG8_WAIT_L(0); PG8_MMA(1, 0, At, B0); PG8_BAR; PG8_SCHED;
            PG8_STAGE(PG8_SB(0, 1), b2 + hstep, voffB);
            PG8_WAIT_V(6); PG8_BAR; PG8_MMA(1, 1, At, B1); PG8_BAR;
            PG8_LDB(B0, 1, 0); PG8_SCHED; PG8_LDA(At, 1, 0); PG8_STAGE(PG8_SA(0, 1), a2 + hstep, voffA);
            PG8_WAIT_L(8); PG8_BAR; PG8_WAIT_L(0); PG8_MMA(0, 0, At, B0); PG8_BAR; PG8_SCHED;
            PG8_LDB(B1, 1, 1); PG8_STAGE(PG8_SB(1, 0), b3, voffB);
            PG8_BAR; PG8_WAIT_L(0); PG8_MMA(0, 1, At, B1); PG8_BAR;
            PG8_LDA(At, 1, 1); PG8_STAGE(PG8_SA(1, 0), a3, voffA);
            PG8_BAR; PG8_WAIT_L(0); PG8_MMA(1, 0, At, B0); PG8_BAR; PG8_SCHED;
            PG8_STAGE(PG8_SB(1, 1), b3 + hstep, voffB);
            PG8_WAIT_V(6); PG8_BAR; PG8_MMA(1, 1, At, B1); PG8_BAR;
        }
        E(acc, cur, wr, wc, fr, fq);
        if (!has_next) break;
#pragma unroll
        for (int a = 0; a < 2; ++a)
#pragma unroll
            for (int b = 0; b < 2; ++b)
#pragma unroll
                for (int m = 0; m < 4; ++m)
#pragma unroll
                    for (int n = 0; n < 2; ++n) acc[a][b][m][n] = (f32x4){0.f, 0.f, 0.f, 0.f};
        cur = nxt; cA = nA; cB = nB; ++ui;
    }
    PG8_WAIT_V(0);
    if (wr == 0) PG8_BAR;
    PG8_BAR;
#undef PG8_SA
#undef PG8_SB
#undef PG8_STAGE
#undef PG8_LDA
#undef PG8_LDB
#undef PG8_MMA
#undef PG8_WAIT_V
#undef PG8_WAIT_L
#undef PG8_BAR
#undef PG8_SCHED
}

__device__ __forceinline__ float silu_mul(float gt, float a) { return gt * a * __builtin_amdgcn_rcpf(1.f + __expf(-gt)); }
__device__ __forceinline__ float dpp_prev1(float prev, float cur) {
    const int o = __builtin_amdgcn_update_dpp(0, __builtin_bit_cast(int, prev), 0x10F, 0xf, 0xf, true);
    return __builtin_bit_cast(float, __builtin_amdgcn_update_dpp(o, __builtin_bit_cast(int, cur), 0x111, 0xf, 0xf, false)); }
__device__ __forceinline__ float dpp_prev2(float prev, float cur) {
    const int o = __builtin_amdgcn_update_dpp(0, __builtin_bit_cast(int, prev), 0x10E, 0xf, 0xf, true);
    return __builtin_bit_cast(float, __builtin_amdgcn_update_dpp(o, __builtin_bit_cast(int, cur), 0x112, 0xf, 0xf, false)); }
__device__ __forceinline__ size_t p_off(int row, int seg, int g) { return ((((size_t)(row >> 7) * 9 + seg) * 4 + g) * 128 + (row & 127)) * 256; }
struct EpiB {
    static constexpr bool PERM = true;
    int mode, l; bf16_t* O; int ldc; bf16_t* KB; bf16_t* VT; float* out; float* ST; bf16_t* Fo; float* HB; const float* cw; const float* cb;
    __device__ __forceinline__ void operator()(const f32x4 (&acc)[2][2][4][2], const Unit& u, int wr, int wc, int fr, int fq) const {
        const int row0 = u.pm * BM + wr * 64 + fr, col0 = u.pn * BM + wc * 32 + 8 * fq;
        if (mode == 0 && u.pm >= MT / BM) {
            const int rr0 = row0 - MT, cc0 = col0 - DIN;
            if (cc0 < 1024) {
                float* ko = out + O_MK + (size_t)l * (MMEM * D);
#pragma unroll
                for (int ai = 0; ai < 2; ++ai)
#pragma unroll
                    for (int m = 0; m < 4; ++m) { const int rr = rr0 + ai * HALF + m * 16;
#pragma unroll
                        for (int bj = 0; bj < 2; ++bj) { const f32x4 v0 = acc[ai][bj][m][0], v1 = acc[ai][bj][m][1]; const size_t o = (size_t)rr * D + cc0 + bj * HALF;
                            *(f32x4*)(ko + o) = v0; *(f32x4*)(ko + o + 4) = v1;
                            u32x4 w; w.x = cvt_pk_bf16(v0[0], v0[1]); w.y = cvt_pk_bf16(v0[2], v0[3]); w.z = cvt_pk_bf16(v1[0], v1[1]); w.w = cvt_pk_bf16(v1[2], v1[3]);
                            *(u32x4*)(KB + o) = w; } }
            } else {
                float* vo = out + O_MV + (size_t)l * (MMEM * D);
#pragma unroll
                for (int ai = 0; ai < 2; ++ai)
#pragma unroll
                    for (int m = 0; m < 4; ++m) { const int rr = rr0 + ai * HALF + m * 16; const int b = rr >> 8, mm = rr & 255;
#pragma unroll
                        for (int bj = 0; bj < 2; ++bj) { const f32x4 v0 = acc[ai][bj][m][0], v1 = acc[ai][bj][m][1]; const int c2 = cc0 - 1024 + bj * HALF;
                            const size_t o = (size_t)rr * D + c2;
                            *(f32x4*)(vo + o) = v0; *(f32x4*)(vo + o + 4) = v1;
                            bf16_t* vt = VT + ((size_t)(b * 4) * 256 + c2) * 256 + mm;
#pragma unroll
                            for (int j = 0; j < 4; ++j) { vt[(size_t)j * 256] = f2bf(v0[j]); vt[(size_t)(4 + j) * 256] = f2bf(v1[j]); } } }
            }
            return;
        }
        if (mode == 0 && u.pn >= 16 && u.pn < 20) {
#pragma unroll
            for (int ai = 0; ai < 2; ++ai)
#pragma unroll
                for (int m = 0; m < 4; ++m) { const f32x4 a0 = acc[ai][0][m][0], a1 = acc[ai][0][m][1], a2 = acc[ai][1][m][0], a3 = acc[ai][1][m][1];
                    const f32x4 sv = (a0 + a1) + (a2 + a3), qv = (a0 * a0 + a1 * a1) + (a2 * a2 + a3 * a3);
                    float ss = (sv[0] + sv[1]) + (sv[2] + sv[3]), qq = (qv[0] + qv[1]) + (qv[2] + qv[3]);
                    ss += __shfl_xor(ss, 16); qq += __shfl_xor(qq, 16); ss += __shfl_xor(ss, 32); qq += __shfl_xor(qq, 32);
                    if (fq == 0) { float* sp = ST + (((size_t)l * MT + row0 + ai * HALF + m * 16) * 16 + (u.pn - 16) * 4 + wc) * 2; sp[0] = ss; sp[1] = qq; } }
        }
        if (mode == 1) {
            const int ca = u.pn * 128 + wc * 32 + 8 * fq;
            if (u.pm >= MP / BM) {
#pragma unroll
                for (int ai = 0; ai < 2; ++ai)
#pragma unroll
                    for (int m = 0; m < 4; ++m) { const int row = row0 + ai * HALF + m * 16; const int q = row - MP, t = q & 3;
#pragma unroll
                        for (int bj = 0; bj < 2; ++bj) { const f32x4 v0 = acc[ai][bj][m][0], v1 = acc[ai][bj][m][1];
                            u32x4 w; w.x = cvt_pk_bf16(v0[0], v0[1]); w.y = cvt_pk_bf16(v0[2], v0[3]); w.z = cvt_pk_bf16(v1[0], v1[1]); w.w = cvt_pk_bf16(v1[2], v1[3]);
                            *(u32x4*)(O + (size_t)row * DFF2 + bj * DFF + ca) = w;
                            if (t >= 2) { float* dst = out + O_CFS + ((size_t)(l * NSEQ + (q >> 2)) * 2 + (t - 2)) * DFF2 + bj * DFF + ca; *(f32x4*)dst = v0; *(f32x4*)(dst + 4) = v1; } } }
                return;
            }
#pragma unroll
            for (int n = 0; n < 2; ++n) {
                const int cn = ca + 4 * n;
                const f32x4 wa0 = *(const f32x4*)(cw + cn), wa1 = *(const f32x4*)(cw + DFF2 + cn), wa2 = *(const f32x4*)(cw + 2 * DFF2 + cn), ba = *(const f32x4*)(cb + cn);
                const f32x4 wg0 = *(const f32x4*)(cw + DFF + cn), wg1 = *(const f32x4*)(cw + DFF2 + DFF + cn), wg2 = *(const f32x4*)(cw + 2 * DFF2 + DFF + cn), bg = *(const f32x4*)(cb + DFF + cn);
#pragma unroll
                for (int ai = 0; ai < 2; ++ai) {
                    const int grow = u.pm * BM + ai * HALF + wr * 64, gi = grow >> 6;
#pragma unroll
                    for (int m = 0; m < 4; ++m) {
                        const int row = grow + 16 * m + fr;
                        const f32x4 ca4 = acc[ai][0][m][n], cg4 = acc[ai][1][m][n], pa4 = acc[ai][0][m > 0 ? m - 1 : 0][n], pg4 = acc[ai][1][m > 0 ? m - 1 : 0][n];
                        f32x4 x1a, x2a, x1g, x2g;
#pragma unroll
                        for (int j = 0; j < 4; ++j) { x1a[j] = dpp_prev1(pa4[j], ca4[j]); x2a[j] = dpp_prev2(pa4[j], ca4[j]); x1g[j] = dpp_prev1(pg4[j], cg4[j]); x2g[j] = dpp_prev2(pg4[j], cg4[j]); }
                        const f32x4 fa = wa0 * x2a + wa1 * x1a + wa2 * ca4 + ba, fg = wg0 * x2g + wg1 * x1g + wg2 * cg4 + bg;
                        if (m > 0 || fr >= 2) { u32x2 w; w.x = cvt_pk_bf16(silu_mul(fg[0], fa[0]), silu_mul(fg[1], fa[1])); w.y = cvt_pk_bf16(silu_mul(fg[2], fa[2]), silu_mul(fg[3], fa[3]));
                            *(u32x2*)(Fo + (size_t)row * DFF + cn) = w; }
                        if ((m == 0 && fr < 2) || (m == 3 && fr >= 14)) {
                            float* hb = HB + ((size_t)gi * 4 + (m == 0 ? fr : fr - 12)) * DFF2 + cn;
                            *(f32x4*)hb = ca4; *(f32x4*)(hb + DFF) = cg4;
                            const int t = row & 2047;
                            if (t >= 2046) { float* dst = out + O_CFP + ((size_t)(l * 8 + (row >> 11)) * 2 + (t - 2046)) * DFF2 + cn; *(f32x4*)dst = ca4; *(f32x4*)(dst + DFF) = cg4; }
                        }
                    }
                }
            }
            return;
        }
#pragma unroll
        for (int ai = 0; ai < 2; ++ai)
#pragma unroll
            for (int m = 0; m < 4; ++m) { const int row = row0 + ai * HALF + m * 16; bf16_t* rowp = O + p_off(row, u.pn >> 2, u.pn & 3) + wc * 32 + 8 * fq;
#pragma unroll
                for (int bj = 0; bj < 2; ++bj) { const f32x4 v0 = acc[ai][bj][m][0], v1 = acc[ai][bj][m][1];
                    u32x4 w; w.x = cvt_pk_bf16(v0[0], v0[1]); w.y = cvt_pk_bf16(v0[2], v0[3]); w.z = cvt_pk_bf16(v1[0], v1[1]); w.w = cvt_pk_bf16(v1[2], v1[3]);
                    *(u32x4*)(rowp + bj * HALF) = w; } }
    }
};
struct EpiRes {
    static constexpr bool PERM = false;
    const float* src_p; const float* src_s; float* dst;
    __device__ __forceinline__ void operator()(const f32x4 (&acc)[2][2][4][2], const Unit& u, int wr, int wc, int fr, int fq) const {
        const int row0 = u.pm * BM + wr * 64 + fr, col0 = u.pn * BM + wc * 32 + 4 * fq;
        const float* sb = (u.pm < MP / BM) ? src_p : (src_s - (size_t)MP * D);
#pragma unroll
        for (int ai = 0; ai < 2; ++ai) {
            f32x4 rv[4][2][2];
#pragma unroll
            for (int m = 0; m < 4; ++m)
#pragma unroll
                for (int bj = 0; bj < 2; ++bj)
#pragma unroll
                    for (int n = 0; n < 2; ++n) rv[m][bj][n] = *(const f32x4*)(sb + (size_t)(row0 + ai * HALF + m * 16) * D + col0 + bj * HALF + n * 16);
            __builtin_amdgcn_sched_barrier(0);
#pragma unroll
            for (int m = 0; m < 4; ++m)
#pragma unroll
                for (int bj = 0; bj < 2; ++bj)
#pragma unroll
                    for (int n = 0; n < 2; ++n) *(f32x4*)(dst + (size_t)(row0 + ai * HALF + m * 16) * D + col0 + bj * HALF + n * 16) = rv[m][bj][n] + acc[ai][bj][m][n];
            __builtin_amdgcn_sched_barrier(0);
        }
    }
};

__device__ __forceinline__ void small_gemm_res(const bf16_t* A, const bf16_t* Bt, int K, const float* src, float* dst, int c, int tid, LAS unsigned char* lds) {
    const int w = __builtin_amdgcn_readfirstlane(tid >> 6), lane = tid & 63, fr = lane & 15, fq = lane >> 4;
    const int cg = w & 3, kh = w >> 2;
    const int row0 = 16 * (c & 31), col0 = 128 * (c >> 5) + 32 * cg, Kh = K >> 1;
    const bf16_t* ap = A + (size_t)(row0 + fr) * K + kh * Kh + 8 * fq;
    const bf16_t* bp = Bt + (size_t)(col0 + fr) * K + kh * Kh + 8 * fq;
    const size_t b16 = (size_t)16 * K;
    f32x4 acc0 = {0.f, 0.f, 0.f, 0.f}, acc1 = acc0;
    struct T { bf16x8 a[4], b0[4], b1[4]; };
    auto ldt = [&](int k) -> T { T t;
#pragma unroll
        for (int i = 0; i < 4; ++i) { t.a[i] = *(const bf16x8*)(ap + k + 32 * i); t.b0[i] = *(const bf16x8*)(bp + k + 32 * i); t.b1[i] = *(const bf16x8*)(bp + b16 + k + 32 * i); }
        return t; };
    auto mma = [&](const T& t) {
#pragma unroll
        for (int i = 0; i < 4; ++i) { acc0 = __builtin_amdgcn_mfma_f32_16x16x32_bf16(t.b0[i], t.a[i], acc0, 0, 0, 0); acc1 = __builtin_amdgcn_mfma_f32_16x16x32_bf16(t.b1[i], t.a[i], acc1, 0, 0, 0); } };
    T t0 = ldt(0);
#pragma unroll 1
    for (int k = 0; k < Kh; k += 256) {
        const bool h1 = k + 128 < Kh, h2 = k + 256 < Kh;
        T t1 = t0;
        if (h1) t1 = ldt(k + 128);
        mma(t0);
        if (h2) t0 = ldt(k + 256);
        if (h1) mma(t1);
    }
    LAS f32x4* ex = (LAS f32x4*)lds + (cg * 64 + lane) * 2;
    if (kh == 1) { ex[0] = acc0; ex[1] = acc1; }
    __syncthreads();
    if (kh == 0) {
        acc0 += ex[0]; acc1 += ex[1];
        const size_t o = (size_t)(row0 + fr) * D + col0 + 4 * fq;
        *(f32x4*)(dst + o) = *(const f32x4*)(src + o) + acc0;
        *(f32x4*)(dst + o + 16) = *(const f32x4*)(src + o + 16) + acc1;
    }
    __syncthreads();
}

__device__ __forceinline__ void transpose_item(const float* W, int K, int N, bf16_t* WT, LAS float* scr, int item, int lane, bool ffn_perm = false) {
    const int nblk = N / 32, kb = item / nblk, nb = item % nblk, k0 = 64 * kb, n0 = 32 * nb;
    const int d0 = !ffn_perm ? n0 : (n0 < DFF ? (n0 >> 7) * 256 + (n0 & 127) : ((n0 - DFF) >> 7) * 256 + 128 + ((n0 - DFF) & 127));
    {
        const int kr = lane >> 3, n4 = lane & 7;
        f32x4 v[8];
#pragma unroll
        for (int i = 0; i < 8; ++i) v[i] = __builtin_nontemporal_load((const f32x4*)(W + (size_t)(k0 + 8 * i + kr) * N + n0 + 4 * n4));
#pragma unroll
        for (int i = 0; i < 8; ++i) { LAS float* d = scr + (8 * i + kr) * 33 + 4 * n4; d[0] = v[i][0]; d[1] = v[i][1]; d[2] = v[i][2]; d[3] = v[i][3]; }
    }
    lds_wait();
    const int c = lane & 7;
#pragma unroll
    for (int j = 0; j < 4; ++j) { const int n = (lane >> 3) + 8 * j; const LAS float* s = scr + (8 * c) * 33 + n;
        u32x4 o; o.x = cvt_pk_bf16(s[0 * 33], s[1 * 33]); o.y = cvt_pk_bf16(s[2 * 33], s[3 * 33]); o.z = cvt_pk_bf16(s[4 * 33], s[5 * 33]); o.w = cvt_pk_bf16(s[6 * 33], s[7 * 33]);
        *(u32x4*)(WT + (size_t)(d0 + n) * K + k0 + 8 * c) = o; }
    lds_wait();
}
template <bool BF>
__device__ __forceinline__ void norm_rows(const float* src, const float* gain, void* dstv, int nrows, int gw, int ngw, int lane) {
    f32x4 gg[4];
#pragma unroll
    for (int j = 0; j < 4; ++j) gg[j] = ((const f32x4*)gain)[lane + 64 * j];
    for (int r = 4 * gw; r < nrows; r += 4 * ngw) {
        f32x4 v[4][4]; float sq[4];
#pragma unroll
        for (int i = 0; i < 4; ++i) { const f32x4* xr = (const f32x4*)(src + (size_t)(r + i) * D) + lane;
#pragma unroll
            for (int j = 0; j < 4; ++j) v[i][j] = xr[64 * j]; }
#pragma unroll
        for (int i = 0; i < 4; ++i) { float t = 0.f;
#pragma unroll
            for (int j = 0; j < 4; ++j) t += (v[i][j][0] * v[i][j][0] + v[i][j][1] * v[i][j][1]) + (v[i][j][2] * v[i][j][2] + v[i][j][3] * v[i][j][3]);
            sq[i] = t; }
#pragma unroll
        for (int o = 1; o < 64; o <<= 1) {
#pragma unroll
            for (int i = 0; i < 4; ++i) sq[i] += __shfl_xor(sq[i], o); }
#pragma unroll
        for (int i = 0; i < 4; ++i) { const float rstd = __builtin_amdgcn_rsqf(sq[i] * (1.f / D) + 1e-6f);
#pragma unroll
            for (int j = 0; j < 4; ++j) { const f32x4 y = v[i][j] * rstd * gg[j];
                if (BF) ((u32x2*)((bf16_t*)dstv + (size_t)(r + i) * D))[lane + 64 * j] = pack4(y); else ((f32x4*)((float*)dstv + (size_t)(r + i) * D))[lane + 64 * j] = y; } }
    }
}
struct F8 { f32x4 a, b; };
__device__ __forceinline__ F8 ld8_bf(const bf16_t* q) { const u32x4 a = *(const u32x4*)q; F8 o; o.a = (f32x4){bf_lo(a.x), bf_hi(a.x), bf_lo(a.y), bf_hi(a.y)}; o.b = (f32x4){bf_lo(a.z), bf_hi(a.z), bf_lo(a.w), bf_hi(a.w)}; return o; }
__device__ __forceinline__ F8 ld8_f(const float* q) { F8 o; o.a = *(const f32x4*)q; o.b = *(const f32x4*)(q + 4); return o; }
__device__ __forceinline__ void v_stats(const bf16_t* vp, int lane, float& mu, float& rstd) {
    const u32x4 a = *(const u32x4*)(vp + 8 * lane), b = *(const u32x4*)(vp + 512 + 8 * lane);
    const f32x4 x0 = {bf_lo(a.x), bf_hi(a.x), bf_lo(a.y), bf_hi(a.y)}, x1 = {bf_lo(a.z), bf_hi(a.z), bf_lo(a.w), bf_hi(a.w)};
    const f32x4 x2 = {bf_lo(b.x), bf_hi(b.x), bf_lo(b.y), bf_hi(b.y)}, x3 = {bf_lo(b.z), bf_hi(b.z), bf_lo(b.w), bf_hi(b.w)};
    const f32x4 sv = (x0 + x1) + (x2 + x3);
    mu = wave_sum((sv[0] + sv[1]) + (sv[2] + sv[3])) * (1.f / 1024.f);
    const f32x4 d0 = x0 - mu, d1 = x1 - mu, d2 = x2 - mu, d3 = x3 - mu;
    const f32x4 qv = (d0 * d0 + d1 * d1) + (d2 * d2 + d3 * d3);
    rstd = 1.f / sqrtf(wave_sum((qv[0] + qv[1]) + (qv[2] + qv[3])) * (1.f / 1024.f) + 1e-6f);
}

constexpr int VS = 136;
constexpr int KS = 528;
constexpr int KSK = 544;
template <int ROWS, bool SWZ = false, int STRIDE = 528>
__device__ __forceinline__ void stage_rows(const bf16_t* src, size_t gstride, LAS unsigned char* dst, int tid) {
    constexpr int N = ROWS * 32 / 512;
    u32x4 v[N];
#pragma unroll
    for (int i = 0; i < N; ++i) { const int idx = tid + 512 * i; v[i] = *(const u32x4*)(src + (size_t)(idx >> 5) * gstride + 8 * (idx & 31)); }
#pragma unroll
    for (int i = 0; i < N; ++i) { const int idx = tid + 512 * i, row = idx >> 5, cch = SWZ ? ((idx & 31) ^ (((row >> 4) & 3) << 2)) : (idx & 31);
        *(LAS u32x4*)(dst + row * STRIDE + 16 * cch) = v[i]; }
}
__device__ __forceinline__ void mixer_prompt(const Params& p, int l, int item, LAS unsigned char* lds, const int tid_in) {
    int tid = tid_in; asm volatile("" : "+v"(tid));
    const int w = __builtin_amdgcn_readfirstlane(tid >> 6), lane = tid & 63, fr = lane & 15, fq = lane >> 4;
    const int T = item >> 2, g = item & 3, r0 = T * 128, b = T >> 4, t0 = (T & 15) * 128;
    const bf16_t* P = (const bf16_t*)(p.ws + WS_P);
    LAS bf16_t* vnT = (LAS bf16_t*)lds;
    LAS float* stats = (LAS float*)(lds + 69632);
    LAS unsigned char* vts = lds + 71680;
    const int r = r0 + 16 * w + fr;
    bf16x8 pb[8];
    {
        bf16x8 qf[8];
#pragma unroll
        for (int k = 0; k < 8; ++k) qf[k] = *(const bf16x8*)(P + p_off(r, 5, g) + 32 * k + 8 * fq);
        stage_rows<256, false, KSK>((const bf16_t*)(p.ws + WS_KB) + (size_t)(b * 256) * D + 256 * g, D, lds, tid);
        __syncthreads();
        f32x4 sc[16];
        const LAS unsigned char* kp = lds + fr * KSK + 16 * fq;
        bf16x8 kfa[8], kfb[8];
#pragma unroll
        for (int k = 0; k < 8; ++k) kfa[k] = *(const LAS bf16x8*)(kp + 64 * k);
#pragma unroll
        for (int n = 0; n < 16; n += 2) {
#pragma unroll
            for (int k = 0; k < 8; ++k) kfb[k] = *(const LAS bf16x8*)(kp + (16 * (n + 1)) * KSK + 64 * k);
            __builtin_amdgcn_sched_barrier(0);
            { f32x4 a = {0.f, 0.f, 0.f, 0.f};
#pragma unroll
              for (int k = 0; k < 8; ++k) a = __builtin_amdgcn_mfma_f32_16x16x32_bf16(kfa[k], qf[k], a, 0, 0, 0);
              sc[n] = a; }
            __builtin_amdgcn_sched_barrier(0);
            if (n + 2 < 16) {
#pragma unroll
                for (int k = 0; k < 8; ++k) kfa[k] = *(const LAS bf16x8*)(kp + (16 * (n + 2)) * KSK + 64 * k); }
            __builtin_amdgcn_sched_barrier(0);
            { f32x4 a = {0.f, 0.f, 0.f, 0.f};
#pragma unroll
              for (int k = 0; k < 8; ++k) a = __builtin_amdgcn_mfma_f32_16x16x32_bf16(kfb[k], qf[k], a, 0, 0, 0);
              sc[n + 1] = a; }
            __builtin_amdgcn_sched_barrier(0);
        }
        float mx = -3.0e38f;
#pragma unroll
        for (int n = 0; n < 16; ++n) mx = fmaxf(fmaxf(mx, fmaxf(sc[n][0], sc[n][1])), fmaxf(sc[n][2], sc[n][3]));
        mx = fmaxf(mx, __shfl_xor(mx, 16)); mx = fmaxf(mx, __shfl_xor(mx, 32));
        float sum = 0.f;
#pragma unroll
        for (int n = 0; n < 16; ++n)
#pragma unroll
            for (int j = 0; j < 4; ++j) { const float e = __expf((sc[n][j] - mx) * 0.0625f); sc[n][j] = e; sum += e; }
        sum += __shfl_xor(sum, 16); sum += __shfl_xor(sum, 32);
        const float inv = 1.f / sum;
#pragma unroll
        for (int kk = 0; kk < 8; ++kk) pb[kk] = pack8(sc[2 * kk] * inv, sc[2 * kk + 1] * inv);
    }
    __syncthreads();
    if (tid < 128) { const f32x4* sp = (const f32x4*)((const float*)(p.ws + WS_ST) + ((size_t)l * MT + r0 + tid) * 32); f32x4 a4 = sp[0];
#pragma unroll
        for (int i = 1; i < 8; ++i) a4 += sp[i];
        const float mu = (a4[0] + a4[2]) * (1.f / 1024.f), var = fmaxf((a4[1] + a4[3]) * (1.f / 1024.f) - mu * mu, 0.f);
        stats[2 * tid] = mu; stats[2 * tid + 1] = 1.f / sqrtf(var + 1e-6f); }
    __syncthreads();
    const bf16_t* Vtg = (const bf16_t*)(p.ws + WS_VT) + ((size_t)(b * 4 + g) * 256) * 256;
    {
        const int s16 = lane & 15, j4 = lane >> 4;
        u32x4 raw[8];
        const int j = w * 4 + j4;
#pragma unroll
        for (int i = 0; i < 8; ++i) raw[i] = __builtin_nontemporal_load((const u32x4*)(P + p_off(r0 + 16 * i + s16, 4, g) + 8 * j));
        const float* lg = p.sg_ln_g + l * 1024 + 256 * g + 8 * j; const f32x4 g0 = *(const f32x4*)lg, g1 = *(const f32x4*)(lg + 4);
#pragma unroll
        for (int i = 0; i < 8; ++i) { const int s = 16 * i + s16;
            const float mu = stats[2 * s], rstd = stats[2 * s + 1];
            LAS bf16_t* d = vnT + (8 * j) * VS + s;
            d[0 * VS] = f2bf((bf_lo(raw[i].x) - mu) * rstd * g0[0]); d[1 * VS] = f2bf((bf_hi(raw[i].x) - mu) * rstd * g0[1]);
            d[2 * VS] = f2bf((bf_lo(raw[i].y) - mu) * rstd * g0[2]); d[3 * VS] = f2bf((bf_hi(raw[i].y) - mu) * rstd * g0[3]);
            d[4 * VS] = f2bf((bf_lo(raw[i].z) - mu) * rstd * g1[0]); d[5 * VS] = f2bf((bf_hi(raw[i].z) - mu) * rstd * g1[1]);
            d[6 * VS] = f2bf((bf_lo(raw[i].w) - mu) * rstd * g1[2]); d[7 * VS] = f2bf((bf_hi(raw[i].w) - mu) * rstd * g1[3]); }
        stage_rows<128, true>(Vtg, 256, vts, tid);
    }
    __syncthreads();
    const int tl = 16 * w + fr, kmax = w >> 1;
    bf16x8 wf[4];
    {
        const float* W = p.sg_w + ((size_t)(l * 4 + g) * 128 + tl) * 128 + 8 * fq;
        f32x4 wl0[4], wl1[4];
#pragma unroll
        for (int k = 0; k < 4; ++k) { wl0[k] = *(const f32x4*)(W + 32 * k); wl1[k] = *(const f32x4*)(W + 32 * k + 4); }
#pragma unroll
        for (int k = 0; k < 4; ++k) {
            f32x4 w0 = wl0[k], w1 = wl1[k];
            const int sb = 32 * k + 8 * fq;
#pragma unroll
            for (int i = 0; i < 4; ++i) { if (sb + i > tl) w0[i] = 0.f; if (sb + 4 + i > tl) w1[i] = 0.f; }
            wf[k] = pack8(w0, w1);
        }
    }
    {
        const float bs = p.sg_b[(l * 4 + g) * 128 + tl];
        const int tb = t0 + tl;
        const float* cw = p.conv_a_w + l * 3 * 1024 + 256 * g + 16 * fq;
        bf16_t* Y = (bf16_t*)(p.ws + WS_Y) + (size_t)r * D + 256 * g + 16 * fq;
        const bf16_t* pc = P + p_off(r, 0, g) + 16 * fq;
        const bf16_t* pcp = P + p_off(r >= 16 ? r - 16 : r, 0, g) + 16 * fq;
        constexpr size_t SEGS = (size_t)4 * 128 * 256;
        float* st = p.out + O_CAP + ((size_t)(l * 8 + b) * 2 + (tb - 2046)) * 1024 + 256 * g + 16 * fq;
        const f32x4 z4 = {0.f, 0.f, 0.f, 0.f};
        const bool ldprev = (fr >= 14) && (tb >= 16);
        struct S5 { u32x4 gm, gb, ga, u, bb, h2, c2, hp, cp; };
        auto load5 = [&](int sidx) -> S5 { const int co = 64 * (sidx >> 1) + 8 * (sidx & 1); S5 q;
            q.gm = *(const u32x4*)(pc + 8 * SEGS + co); q.gb = *(const u32x4*)(pc + 7 * SEGS + co); q.ga = *(const u32x4*)(pc + 6 * SEGS + co); q.u = *(const u32x4*)(pc + 3 * SEGS + co); q.bb = *(const u32x4*)(pc + 2 * SEGS + co);
            q.h2 = *(const u32x4*)(pc + co); q.c2 = *(const u32x4*)(pc + SEGS + co);
            const u32x4 zz = {0u, 0u, 0u, 0u};
            if (ldprev) { q.hp = *(const u32x4*)(pcp + co); q.cp = *(const u32x4*)(pcp + SEGS + co); } else { q.hp = zz; q.cp = zz; }
            return q; };
        auto up8 = [](const u32x4& a) -> F8 { F8 o; o.a = (f32x4){bf_lo(a.x), bf_hi(a.x), bf_lo(a.y), bf_hi(a.y)}; o.b = (f32x4){bf_lo(a.z), bf_hi(a.z), bf_lo(a.w), bf_hi(a.w)}; return o; };
        auto step5 = [&](const S5& q, int co, const f32x4& oa, const f32x4& ob, const f32x4& sga, const f32x4& sgb) {
            const F8 w0 = ld8_f(cw + co), w1 = ld8_f(cw + 1024 + co), w2 = ld8_f(cw + 2048 + co);
            const F8 h2 = up8(q.h2), c2 = up8(q.c2), hp = up8(q.hp), cp = up8(q.cp);
            const f32x4 ch2a = c2.a * h2.a, ch2b = c2.b * h2.b, chpa = cp.a * hp.a, chpb = cp.b * hp.b;
            f32x4 ch1a, ch1b, ch0a, ch0b;
#pragma unroll
            for (int j = 0; j < 4; ++j) { ch1a[j] = dpp_prev1(chpa[j], ch2a[j]); ch0a[j] = dpp_prev2(chpa[j], ch2a[j]); ch1b[j] = dpp_prev1(chpb[j], ch2b[j]); ch0b[j] = dpp_prev2(chpb[j], ch2b[j]); }
            const F8 bb = up8(q.bb);
            const f32x4 yaa = bb.a * (w0.a * ch0a + w1.a * ch1a + w2.a * ch2a), yab = bb.b * (w0.b * ch0b + w1.b * ch1b + w2.b * ch2b);
            const F8 gm = up8(q.gm), gb = up8(q.gb), ga = up8(q.ga), u = up8(q.u);
            f32x4 ya, yb;
#pragma unroll
            for (int j = 0; j < 4; ++j) { ya[j] = sigm(gm.a[j]) * oa[j] + sigm(gb.a[j]) * u.a[j] * (sga[j] + bs) + sigm(ga.a[j]) * yaa[j];
                yb[j] = sigm(gm.b[j]) * ob[j] + sigm(gb.b[j]) * u.b[j] * (sgb[j] + bs) + sigm(ga.b[j]) * yab[j]; }
            if (tb >= 2046) { *(f32x4*)(st + co) = ch2a; *(f32x4*)(st + co + 4) = ch2b; }
            u32x4 wv; wv.x = cvt_pk_bf16(ya[0], ya[1]); wv.y = cvt_pk_bf16(ya[2], ya[3]); wv.z = cvt_pk_bf16(yb[0], yb[1]); wv.w = cvt_pk_bf16(yb[2], yb[3]);
            *(u32x4*)(Y + co) = wv; };
        S5 cur = load5(0);
#pragma unroll 1
        for (int A = 0; A < 4; ++A) {
            if (A == 2) { __syncthreads(); stage_rows<128, true>(Vtg + 128 * 256, 256, vts, tid); __syncthreads(); }
            const int dbase = 64 * A + 16 * (fr >> 2) + (fr & 3);
            const S5 n1 = load5(2 * A + 1);
#pragma unroll
            for (int hlf = 0; hlf < 2; ++hlf) {
                f32x4 o[2], sa[2];
#pragma unroll
                for (int e = 0; e < 2; ++e) { f32x4 acc = z4; const LAS unsigned char* vrow = vts + ((dbase & 127) + 4 * (2 * hlf + e)) * KS + 8 * fq;
                    u32x4 vv[8];
#pragma unroll
                    for (int kk = 0; kk < 8; ++kk) { const int ko = 64 * (kk ^ (fr >> 2)); const u32x2 lo = *(const LAS u32x2*)(vrow + ko), hi = *(const LAS u32x2*)(vrow + ko + 32); vv[kk] = (u32x4){lo.x, lo.y, hi.x, hi.y}; }
                    __builtin_amdgcn_sched_barrier(0);
#pragma unroll
                    for (int kk = 0; kk < 8; ++kk) acc = __builtin_amdgcn_mfma_f32_16x16x32_bf16(__builtin_bit_cast(bf16x8, vv[kk]), pb[kk], acc, 0, 0, 0);
                    __builtin_amdgcn_sched_barrier(0);
                    o[e] = acc; }
#pragma unroll
                for (int e = 0; e < 2; ++e) { f32x4 acc = z4;
#pragma unroll
                    for (int k = 0; k < 4; ++k) if (k <= kmax) { const bf16x8 vf = *(const LAS bf16x8*)(vnT + (dbase + 4 * (2 * hlf + e)) * VS + 32 * k + 8 * fq); acc = __builtin_amdgcn_mfma_f32_16x16x32_bf16(vf, wf[k], acc, 0, 0, 0); }
                    sa[e] = acc; }
                if (hlf == 0) { step5(cur, 64 * A, o[0], o[1], sa[0], sa[1]); if (A < 3) cur = load5(2 * A + 2); }
                else step5(n1, 64 * A + 8, o[0], o[1], sa[0], sa[1]);
            }
        }
    }
    __syncthreads();
}

__device__ __forceinline__ void mixer_sample(const Params& p, int l, int item, LAS unsigned char* lds, const int tid_in) {
    int tid = tid_in; asm volatile("" : "+v"(tid));
    const int w = __builtin_amdgcn_readfirstlane(tid >> 6), lane = tid & 63, fr = lane & 15, fq = lane >> 4;
    const int s = item >> 2, g = item & 3, r0 = MP + 4 * s;
    const bf16_t* P = (const bf16_t*)(p.ws + WS_P);
    LAS float* st = (LAS float*)lds;
    LAS float* sc = (LAS float*)(lds + 1024);
    LAS float* pT = (LAS float*)(lds + 8192);
    LAS float* op = (LAS float*)(lds + 16384);
    if (tid < 4) { const f32x4* sp = (const f32x4*)((const float*)(p.ws + WS_ST) + ((size_t)l * MT + r0 + tid) * 32); f32x4 a4 = sp[0];
#pragma unroll
        for (int i = 1; i < 8; ++i) a4 += sp[i];
        const float mu = (a4[0] + a4[2]) * (1.f / 1024.f), var = fmaxf((a4[1] + a4[3]) * (1.f / 1024.f) - mu * mu, 0.f);
        st[2 * tid] = mu; st[2 * tid + 1] = 1.f / sqrtf(var + 1e-6f); }
    const size_t cbase = (((size_t)l * NSEQ + s) * 256 * 4 + g) * 256;
    {
        bf16x8 qf[8];
        const bf16_t* qp = P + p_off(r0 + (fr & 3), 5, g) + 8 * fq;
#pragma unroll
        for (int k = 0; k < 8; ++k) { qf[k] = *(const bf16x8*)(qp + 32 * k); if (fr >= 4) qf[k] = (bf16x8){0, 0, 0, 0, 0, 0, 0, 0}; }
        const float* Kc = p.cache_mem_k + cbase + (size_t)(32 * w + fr) * 1024 + 8 * fq;
        f32x4 kx[2][8][2];
#pragma unroll
        for (int nb = 0; nb < 2; ++nb)
#pragma unroll
            for (int k = 0; k < 8; ++k) { const float* kp = Kc + (size_t)(16 * nb) * 1024 + 32 * k;
                kx[nb][k][0] = __builtin_nontemporal_load((const f32x4*)kp); kx[nb][k][1] = __builtin_nontemporal_load((const f32x4*)(kp + 4)); }
        __builtin_amdgcn_sched_barrier(0);
#pragma unroll
        for (int nb = 0; nb < 2; ++nb) { f32x4 a = {0.f, 0.f, 0.f, 0.f};
#pragma unroll
            for (int k = 0; k < 8; ++k) a = __builtin_amdgcn_mfma_f32_16x16x32_bf16(pack8(kx[nb][k][0], kx[nb][k][1]), qf[k], a, 0, 0, 0);
            if (fr < 4) {
#pragma unroll
                for (int j = 0; j < 4; ++j) sc[fr * 256 + 32 * w + 16 * nb + 4 * fq + j] = a[j] * 0.0625f; } }
    }
    f32x4 vr[32];
    {
        const float* Vc = p.cache_mem_v + cbase + (size_t)(32 * w) * 1024 + 4 * lane;
#pragma unroll
        for (int mm = 0; mm < 32; ++mm) vr[mm] = __builtin_nontemporal_load((const f32x4*)(Vc + (size_t)mm * 1024));
    }
    __syncthreads();
    if (w < 4) {
        const f32x4 v = *(const LAS f32x4*)(sc + w * 256 + 4 * lane);
        const float mx = wave_max(fmaxf(fmaxf(v[0], v[1]), fmaxf(v[2], v[3])));
        f32x4 e = {__expf(v[0] - mx), __expf(v[1] - mx), __expf(v[2] - mx), __expf(v[3] - mx)};
        const float inv = 1.f / wave_sum((e[0] + e[1]) + (e[2] + e[3]));
#pragma unroll
        for (int i = 0; i < 4; ++i) pT[(4 * lane + i) * 4 + w] = e[i] * inv;
    }
    __syncthreads();
    {
        f32x4 o0 = {0.f, 0.f, 0.f, 0.f}, o1 = o0, o2 = o0, o3 = o0;
#pragma unroll
        for (int mm = 0; mm < 32; ++mm) { const f32x4 v = vr[mm]; const f32x4 pp = *(const LAS f32x4*)(pT + 4 * (32 * w + mm));
            o0 += pp[0] * v; o1 += pp[1] * v; o2 += pp[2] * v; o3 += pp[3] * v; }
        *(LAS f32x4*)(op + (w * 4 + 0) * 256 + 4 * lane) = o0; *(LAS f32x4*)(op + (w * 4 + 1) * 256 + 4 * lane) = o1;
        *(LAS f32x4*)(op + (w * 4 + 2) * 256 + 4 * lane) = o2; *(LAS f32x4*)(op + (w * 4 + 3) * 256 + 4 * lane) = o3;
    }
    __syncthreads();
    if (tid < 256) {
        const int cc = 256 * g + tid;
        constexpr size_t SEGS = (size_t)4 * 128 * 256;
        bf16_t pv[4][8];
#pragma unroll
        for (int t = 0; t < 4; ++t) { const bf16_t* q = P + p_off(r0 + t, 0, g) + tid;
            pv[t][0] = q[0]; pv[t][1] = q[SEGS]; pv[t][2] = q[2 * SEGS]; pv[t][3] = q[3 * SEGS]; pv[t][4] = q[4 * SEGS]; pv[t][5] = q[6 * SEGS]; pv[t][6] = q[7 * SEGS]; pv[t][7] = q[8 * SEGS]; }
        const float lg = p.sg_ln_g[l * 1024 + cc];
        const float* Wg = p.sg_w + (size_t)(l * 4 + g) * 128 * 128; const float* bg = p.sg_b + (l * 4 + g) * 128;
        const float cw0 = p.conv_a_w[l * 3072 + cc], cw1 = p.conv_a_w[l * 3072 + 1024 + cc], cw2 = p.conv_a_w[l * 3072 + 2048 + cc];
        float x[6];
        x[0] = p.cache_conv_a[((size_t)(l * NSEQ + s) * 2 + 0) * 1024 + cc]; x[1] = p.cache_conv_a[((size_t)(l * NSEQ + s) * 2 + 1) * 1024 + cc];
        const f32x4 wr0 = *(const f32x4*)(Wg), wr1 = *(const f32x4*)(Wg + 128), wr2 = *(const f32x4*)(Wg + 256), wr3 = *(const f32x4*)(Wg + 384), bgv = *(const f32x4*)bg;
        __builtin_amdgcn_sched_barrier(0);
        float ym[4];
#pragma unroll
        for (int t = 0; t < 4; ++t) { float a = 0.f;
#pragma unroll
            for (int ww = 0; ww < 8; ++ww) a += op[(ww * 4 + t) * 256 + tid];
            ym[t] = a; }
        float vn[4];
#pragma unroll
        for (int t = 0; t < 4; ++t) { vn[t] = (bf2f(pv[t][4]) - st[2 * t]) * st[2 * t + 1] * lg; x[2 + t] = bf2f(pv[t][1]) * bf2f(pv[t][0]); }
        const float sg0 = bgv[0] + wr0[0] * vn[0];
        const float sg1 = bgv[1] + wr1[0] * vn[0] + wr1[1] * vn[1];
        const float sg2 = bgv[2] + wr2[0] * vn[0] + wr2[1] * vn[1] + wr2[2] * vn[2];
        const float sg3 = bgv[3] + wr3[0] * vn[0] + wr3[1] * vn[1] + wr3[2] * vn[2] + wr3[3] * vn[3];
        const float sgv[4] = {sg0, sg1, sg2, sg3};
        float yv[4];
#pragma unroll
        for (int t = 0; t < 4; ++t) {
            const float yb = bf2f(pv[t][3]) * sgv[t];
            const float ya = bf2f(pv[t][2]) * (cw0 * x[t] + cw1 * x[t + 1] + cw2 * x[t + 2]);
            yv[t] = sigm(bf2f(pv[t][5])) * ya + sigm(bf2f(pv[t][6])) * yb + sigm(bf2f(pv[t][7])) * ym[t];
        }
        bf16_t* Y = (bf16_t*)(p.ws + WS_Y) + (size_t)r0 * D + cc;
#pragma unroll
        for (int t = 0; t < 4; ++t) { p.out[O_SV + ((size_t)(l * NSEQ + s) * 4 + t) * 1024 + cc] = vn[t]; Y[(size_t)t * D] = f2bf(yv[t]); }
        p.out[O_CAS + ((size_t)(l * NSEQ + s) * 2 + 0) * 1024 + cc] = x[4]; p.out[O_CAS + ((size_t)(l * NSEQ + s) * 2 + 1) * 1024 + cc] = x[5];
    }
    __syncthreads();
}

__device__ __forceinline__ F8 fma3(const F8& w0, const F8& x0, const F8& w1, const F8& x1, const F8& w2, const F8& x2, const F8& bb) {
    F8 o; o.a = w0.a * x0.a + w1.a * x1.a + w2.a * x2.a + bb.a; o.b = w0.b * x0.b + w1.b * x1.b + w2.b * x2.b + bb.b; return o; }
__device__ __forceinline__ void ffn_store(bf16_t* dst, const F8& av, const F8& gv) {
    u32x4 o;
    o.x = cvt_pk_bf16(silu_mul(gv.a[0], av.a[0]), silu_mul(gv.a[1], av.a[1])); o.y = cvt_pk_bf16(silu_mul(gv.a[2], av.a[2]), silu_mul(gv.a[3], av.a[3]));
    o.z = cvt_pk_bf16(silu_mul(gv.b[0], av.b[0]), silu_mul(gv.b[1], av.b[1])); o.w = cvt_pk_bf16(silu_mul(gv.b[2], av.b[2]), silu_mul(gv.b[3], av.b[3]));
    *(u32x4*)dst = o; }
__device__ __forceinline__ void ffn_elem(const Params& p, int l, int gw, int ngw, int lane) {
    const bf16_t* H = (const bf16_t*)(p.ws + WS_H); bf16_t* F = (bf16_t*)(p.ws + WS_F); const float* HB = (const float*)(p.ws + WS_HB);
    const float* cw = p.conv_f_w + (size_t)l * 3 * DFF2; const float* cb = p.conv_f_b + (size_t)l * DFF2;
    const f32x4 z4 = {0.f, 0.f, 0.f, 0.f};
    constexpr int NCB = 6;
    for (int it = gw; it < 256 * NCB; it += ngw) {
        const int gi = it / NCB, j = (it % NCB) * 64 + lane;
        if (j >= 352) continue;
        const int col = 8 * j; const bool first = (gi & 31) == 0;
        const F8 wa0 = ld8_f(cw + col), wa1 = ld8_f(cw + DFF2 + col), wa2 = ld8_f(cw + 2 * DFF2 + col), ba = ld8_f(cb + col);
        const F8 wg0 = ld8_f(cw + DFF + col), wg1 = ld8_f(cw + DFF2 + DFF + col), wg2 = ld8_f(cw + 2 * DFF2 + DFF + col), bg = ld8_f(cb + DFF + col);
        const float* hb = HB + (size_t)gi * 4 * DFF2 + col;
        F8 a0, a1, g0, g1;
        if (!first) { a0 = ld8_f(hb - 2 * DFF2); g0 = ld8_f(hb - 2 * DFF2 + DFF); a1 = ld8_f(hb - DFF2); g1 = ld8_f(hb - DFF2 + DFF); }
        else { a0.a = z4; a0.b = z4; a1 = a0; g0 = a0; g1 = a0; }
        const F8 xa0 = ld8_f(hb), xg0 = ld8_f(hb + DFF), xa1 = ld8_f(hb + DFF2), xg1 = ld8_f(hb + DFF2 + DFF);
        bf16_t* fp = F + (size_t)(64 * gi) * DFF + col;
        ffn_store(fp, fma3(wa0, a0, wa1, a1, wa2, xa0, ba), fma3(wg0, g0, wg1, g1, wg2, xg0, bg));
        ffn_store(fp + DFF, fma3(wa0, a1, wa1, xa0, wa2, xa1, ba), fma3(wg0, g1, wg1, xg0, wg2, xg1, bg));
    }
    for (int it = gw; it < NSEQ * NCB; it += ngw) {
        const int sq = it / NCB, j = (it % NCB) * 64 + lane;
        if (j >= 352) continue;
        const int col = 8 * j, rq = MP + 4 * sq;
        const F8 wa0 = ld8_f(cw + col), wa1 = ld8_f(cw + DFF2 + col), wa2 = ld8_f(cw + 2 * DFF2 + col), ba = ld8_f(cb + col);
        const F8 wg0 = ld8_f(cw + DFF + col), wg1 = ld8_f(cw + DFF2 + DFF + col), wg2 = ld8_f(cw + 2 * DFF2 + DFF + col), bg = ld8_f(cb + DFF + col);
        const float* cc = p.cache_conv_ffn + ((size_t)(l * NSEQ + sq) * 2) * DFF2 + col;
        const F8 a0 = ld8_f(cc), g0 = ld8_f(cc + DFF), a1 = ld8_f(cc + DFF2), g1 = ld8_f(cc + DFF2 + DFF);
        const bf16_t* hp = H + (size_t)rq * DFF2 + col;
        const F8 xa0 = ld8_bf(hp), xg0 = ld8_bf(hp + DFF), xa1 = ld8_bf(hp + DFF2), xg1 = ld8_bf(hp + DFF2 + DFF);
        const F8 xa2 = ld8_bf(hp + 2 * DFF2), xg2 = ld8_bf(hp + 2 * DFF2 + DFF), xa3 = ld8_bf(hp + 3 * DFF2), xg3 = ld8_bf(hp + 3 * DFF2 + DFF);
        bf16_t* fp = F + (size_t)rq * DFF + col;
        ffn_store(fp, fma3(wa0, a0, wa1, a1, wa2, xa0, ba), fma3(wg0, g0, wg1, g1, wg2, xg0, bg));
        ffn_store(fp + DFF, fma3(wa0, a1, wa1, xa0, wa2, xa1, ba), fma3(wg0, g1, wg1, xg0, wg2, xg1, bg));
        ffn_store(fp + 2 * DFF, fma3(wa0, xa0, wa1, xa1, wa2, xa2, ba), fma3(wg0, xg0, wg1, xg1, wg2, xg2, bg));
        ffn_store(fp + 3 * DFF, fma3(wa0, xa1, wa1, xa2, wa2, xa3, ba), fma3(wg0, xg1, wg1, xg2, wg2, xg3, bg));
    }
}

__device__ __forceinline__ int lane_id() { unsigned z = 0u; asm volatile("" : "+v"(z)); return (int)__builtin_amdgcn_mbcnt_hi(~0u, __builtin_amdgcn_mbcnt_lo(~0u, z)); }
#define XB_TMO      128
#define XB_XCNT(j)  (256  + 64 * (j))
#define XB_XSUB(j)  (1280 + 64 * (j))
#define XB_XGEN(j)  (2304 + 64 * (j))
#define XB_TOP      3328
#define XB_TOPGEN   3392
#define XCD_BAR_WORDS 3456
#define XB_SPIN_CAP (1u << 18)
__device__ __forceinline__ unsigned xb_ld(unsigned* p)              { return __hip_atomic_load(p, __ATOMIC_RELAXED, __HIP_MEMORY_SCOPE_AGENT); }
__device__ __forceinline__ unsigned xb_add(unsigned* p, unsigned v) { return __hip_atomic_fetch_add(p, v, __ATOMIC_RELAXED, __HIP_MEMORY_SCOPE_AGENT); }
__device__ __forceinline__ unsigned xb_xcc_id() { return (unsigned)__builtin_amdgcn_s_getreg((3 << 11) | 20) & 0xFu; }
#define XB_SPIN(cond, bar) do { unsigned _sp = 0; while (cond) { __builtin_amdgcn_s_sleep(1); \
    if ((++_sp & 255u) == 0u) { if (xb_ld(&(bar)[XB_TMO])) break; if (_sp > XB_SPIN_CAP) { atomicAdd(&(bar)[XB_TMO], 1u); break; } } } } while (0)
struct XcdBarrier { unsigned* bar; unsigned x; volatile LAS unsigned* st; };
__device__ __forceinline__ XcdBarrier xcd_barrier_post(unsigned* bar, volatile LAS unsigned* st, bool leader) {
    XcdBarrier b; b.bar = bar; b.x = xb_xcc_id(); b.st = st;
    if (leader) (void)xb_add(&bar[XB_XCNT(b.x)], 1u);
    return b;
}
__device__ __forceinline__ void xcd_barrier_complete(unsigned* bar, unsigned x, unsigned& nloc, unsigned& nx) {
    const unsigned G = gridDim.x * gridDim.y * gridDim.z;
    unsigned sum, cnt, mine, sp = 0u;
    for (;;) {
        sum = 0u; cnt = 0u; mine = 0u;
#pragma unroll
        for (unsigned j = 0; j < 16; ++j) { const unsigned c = xb_ld(&bar[XB_XCNT(j)]); sum += c; cnt += (c > 0u) ? 1u : 0u; mine = (j == x) ? c : mine; }
        if (sum == G) break;
        __builtin_amdgcn_s_sleep(1);
        if ((++sp & 255u) == 0u) { if (xb_ld(&bar[XB_TMO])) break; if (sp > XB_SPIN_CAP) { atomicAdd(&bar[XB_TMO], 1u); break; } }
    }
    nloc = mine > 0u ? mine : 1u; nx = cnt > 0u ? cnt : 1u;
}
__device__ __forceinline__ void xcd_barrier(const XcdBarrier& b, const int wave0) {
    asm volatile("s_waitcnt vmcnt(0)" ::: "memory");
    __syncthreads();
    if (wave0 == 0 && lane_id() == 0) {
        unsigned* bar = b.bar; asm volatile("" : "+s"(bar));
        unsigned bx = b.x; asm volatile("" : "+s"(bx));
        __builtin_amdgcn_s_waitcnt(0);
        unsigned nloc = b.st[0], nx = b.st[1];
        if (nloc == 0u) { xcd_barrier_complete(bar, bx, nloc, nx); b.st[0] = nloc; b.st[1] = nx; }
        const unsigned old = xb_add(&bar[XB_XSUB(bx)], 1u);
        const unsigned gen = old / nloc;
        if (old + 1u == (gen + 1u) * nloc) {
            __builtin_amdgcn_fence(__ATOMIC_RELEASE, "agent");
            asm volatile("s_waitcnt vmcnt(0)" ::: "memory");
            const unsigned og = xb_add(&bar[XB_TOP], 1u);
            const unsigned tg = og / nx;
            if (og + 1u == (tg + 1u) * nx) xb_add(&bar[XB_TOPGEN], 1u);
            else XB_SPIN(xb_ld(&bar[XB_TOPGEN]) == tg, bar);
            __builtin_amdgcn_fence(__ATOMIC_ACQUIRE, "agent");
            xb_add(&bar[XB_XGEN(bx)], 1u);
            asm volatile("s_waitcnt vmcnt(0)" ::: "memory");
        } else {
            XB_SPIN(xb_ld(&bar[XB_XGEN(bx)]) == gen, bar);
            __builtin_amdgcn_fence(__ATOMIC_ACQUIRE, "agent");
            asm volatile("s_waitcnt vmcnt(0)" ::: "memory");
        }
    }
    __syncthreads();
}

__global__ void __launch_bounds__(512, 2) fwd_megakernel(Params p) {
    extern __shared__ __attribute__((aligned(16))) unsigned char shm[];
    LAS unsigned char* lds = (LAS unsigned char*)shm;
    cg::grid_group grid = cg::this_grid();
    volatile LAS unsigned* xb_st = (volatile LAS unsigned*)(lds + LDS_BYTES - 16);
    const int wave0 = __builtin_amdgcn_readfirstlane((int)threadIdx.x >> 6);
    const bool leader0 = (wave0 == 0) && (lane_id() == 0);
    if (leader0) { xb_st[0] = 0u; xb_st[1] = 0u; }
    __syncthreads();
    const XcdBarrier xb = xcd_barrier_post((unsigned*)(p.ws + WS_BAR), xb_st, leader0);
    const int G = gridDim.x, c = blockIdx.x, ngw = G * 8;
    bf16_t* WT = (bf16_t*)(p.ws + WS_WT);
    bf16_t* ZA = (bf16_t*)(p.ws + WS_ZA);
    float* X = (float*)(p.ws + WS_X);

#pragma unroll 1
    for (int rep0 = 0; rep0 < (((DUP_MASK >> 8) & 1) ? 2 : 1); ++rep0) {
        const int lane = lane_id(), wave = wave0, tid = wave0 * 64 + lane, gw = c * 8 + wave;
        LAS float* scr = (LAS float*)(lds + wave * 8448);
        constexpr int I_IN = 16 * (DIN / 32), I_K = 16 * 32, I_O = 16 * 32, I_UP = 16 * (DFF2 / 32), I_DN = (DFF / 64) * 32, I_L = I_IN + 2 * I_K + I_O + I_UP + I_DN;
        for (int it = gw; it < 2 * I_L; it += ngw) {
            const int l = it / I_L; int r = it % I_L; bf16_t* wl = WT + (size_t)l * WL_SZ;
            if (r < I_IN) { transpose_item(p.w_in + (size_t)l * D * DIN, D, DIN, wl + WL_IN, scr, r, lane); continue; } r -= I_IN;
            if (r < I_K) { transpose_item(p.w_k + (size_t)l * D * D, D, D, wl + WL_KV, scr, r, lane); continue; } r -= I_K;
            if (r < I_K) { transpose_item(p.w_v + (size_t)l * D * D, D, D, wl + WL_KV + (size_t)D * D, scr, r, lane); continue; } r -= I_K;
            if (r < I_O) { transpose_item(p.w_o + (size_t)l * D * D, D, D, wl + WL_O, scr, r, lane); continue; } r -= I_O;
            if (r < I_UP) { transpose_item(p.w_up + (size_t)l * D * DFF2, D, DFF2, wl + WL_UP, scr, r, lane, true); continue; } r -= I_UP;
            transpose_item(p.w_down + (size_t)l * DFF * D, DFF, D, wl + WL_DN, scr, r, lane);
        }
        norm_rows<true>(p.x_prompt, p.norm_mix_g, ZA, MP, gw, ngw, lane);
        norm_rows<true>(p.x_sample, p.norm_mix_g, ZA + (size_t)MP * D, MS, gw, ngw, lane);
        norm_rows<true>(p.mem_prompt, p.norm_mem_g, ZA + (size_t)MT * D, MMEM, gw, ngw, lane);
    }
    if (p.ws == nullptr) grid.sync();
    xcd_barrier(xb, wave0);

#pragma unroll 1
    for (int ph = 0; ph < 16; ++ph) {
        const int l = ph >> 3, sub = ph & 7;
        const bf16_t* wl = WT + (size_t)l * WL_SZ;
        const int nrep = ((DUP_MASK >> sub) & 1) ? 2 : 1;
#pragma unroll 1
        for (int rep = 0; rep < nrep; ++rep) {
        if (rep) xcd_barrier(xb, wave0);
        int lane = lane_id(); asm volatile("" : "+v"(lane));
        const int wave = wave0, tid = wave0 * 64 + lane, gw = c * 8 + wave;
        if (sub == 0 || sub == 4) {
            Gemm g; Sched S; EpiB E;
            S.G = G; S.c = c; S.nM = MT / BM; E.l = l; E.KB = (bf16_t*)(p.ws + WS_KB); E.VT = (bf16_t*)(p.ws + WS_VT); E.out = p.out; E.ST = (float*)(p.ws + WS_ST); E.Fo = (bf16_t*)(p.ws + WS_F); E.HB = (float*)(p.ws + WS_HB); E.cw = p.conv_f_w + (size_t)l * 3 * DFF2; E.cb = p.conv_f_b + (size_t)l * DFF2; g.K = D; g.A = ZA;
            if (sub == 0) { g.Bt = wl + WL_IN; S.nN = DIN / BM; S.extra = 64; S.xpm0 = MT / BM; S.xpn0 = DIN / BM; E.mode = 0; E.O = (bf16_t*)(p.ws + WS_P); E.ldc = DIN; }
            else { g.Bt = wl + WL_UP; S.nN = DFF2 / BM; S.extra = 0; S.xpm0 = 0; S.xpn0 = 0; E.mode = 1; E.O = (bf16_t*)(p.ws + WS_H); E.ldc = DFF2; }
            S.nwg = S.nM * S.nN;
            gemm_phase<EpiB, D>(lds, tid, g, S, E);
        } else if (sub == 2 || sub == 6) {
            Gemm g; Sched S; EpiRes E;
            S.G = G; S.c = c; S.nM = MP / BM; S.nN = D / BM; S.nwg = S.nM * S.nN; S.extra = 0; S.xpm0 = 0; S.xpn0 = 0;
            E.dst = X; E.src_p = X; E.src_s = X + (size_t)MP * D;
            if (sub == 2) { g.A = (const bf16_t*)(p.ws + WS_Y); g.Bt = wl + WL_O; g.K = D; if (l == 0) { E.src_p = p.x_prompt; E.src_s = p.x_sample; } }
            else { g.A = (const bf16_t*)(p.ws + WS_F); g.Bt = wl + WL_DN; g.K = DFF; }
            if (nrep == 2 && rep == 0) E.dst = (float*)(p.ws + WS_H);
            gemm_phase<EpiRes>(lds, tid, g, S, E);
            for (int uu = c; uu < 256; uu += G) small_gemm_res(g.A + (size_t)MP * g.K, g.Bt, g.K, E.src_s, E.dst + (size_t)MP * D, uu, tid, lds);
        } else if (sub == 1) {
            for (int k = 0; k < 4; ++k) {
                const int kk = k ^ 2;
                const int item = c + (kk & 1) * G;
#ifdef DUP_MIX_MODE
                if (nrep == 2 && rep == 0 && ((kk < 2) != (DUP_MIX_MODE == 1))) continue;
#endif
                if (item < 512) { if (kk < 2) mixer_prompt(p, l, item, lds, tid); else mixer_sample(p, l, item, lds, tid); }
            }
            for (int item = c + 2 * G; item < 512; item += G) { mixer_prompt(p, l, item, lds, tid); mixer_sample(p, l, item, lds, tid); }
        } else if (sub == 3) {
            norm_rows<true>(X, p.norm_ffn_g + l * D, ZA, MT, gw, ngw, lane);
        } else if (sub == 5) {
            ffn_elem(p, l, gw, ngw, lane);
        } else {
            if (l == 0) { norm_rows<true>(X, p.norm_mix_g + D, ZA, MT, gw, ngw, lane); norm_rows<true>(p.mem_prompt, p.norm_mem_g + D, ZA + (size_t)MT * D, MMEM, gw, ngw, lane); }
            else norm_rows<false>(X, p.norm_final_g, p.out + O_YP, MT, gw, ngw, lane);
        }
        }
#ifdef EXTRA_SYNCS
        for (int es = 0; es < EXTRA_SYNCS; ++es) xcd_barrier(xb, wave0);
#endif
        if (ph < 15) xcd_barrier(xb, wave0);
    }
}

extern "C" void kernel_launch(void* const* d_in, const int* in_sizes, int n_in, void* d_out, int out_size, void* d_ws, size_t ws_size, hipStream_t stream) {
    static int grid_blocks = 0;
    if (grid_blocks == 0) {
        if (n_in != 23 || ws_size < WS_END) { fprintf(stderr, "kernel_launch: unexpected n_in %d or ws_size %zu (< %zu)\n", n_in, ws_size, (size_t)WS_END); grid_blocks = -1; return; }
        int dev = 0, cus = 0, per_cu = 0;
        hipGetDevice(&dev);
        hipDeviceGetAttribute(&cus, hipDeviceAttributeMultiprocessorCount, dev);
        hipFuncSetAttribute((const void*)fwd_megakernel, hipFuncAttributeMaxDynamicSharedMemorySize, LDS_BYTES);
        hipOccupancyMaxActiveBlocksPerMultiprocessor(&per_cu, (const void*)fwd_megakernel, 512, LDS_BYTES);
        if (per_cu < 1) { fprintf(stderr, "kernel_launch: occupancy query reports %d blocks per CU\n", per_cu); grid_blocks = -1; return; }
        grid_blocks = cus;
    }
    if (grid_blocks < 0) return;
    if (hipMemsetAsync((char*)d_ws + WS_BAR, 0, 16384, stream) != hipSuccess) { fprintf(stderr, "kernel_launch: memset of the barrier words failed\n"); return; }
    Params p{};
    const float** pp = (const float**)&p;
    for (int i = 0; i < 23; ++i) pp[i] = (const float*)d_in[i];
    p.out = (float*)d_out; p.ws = (unsigned char*)d_ws;
    void* args[] = {&p};
    hipError_t e = hipLaunchCooperativeKernel((const void*)fwd_megakernel, dim3(grid_blocks), dim3(512), args, LDS_BYTES, stream);
    if (e != hipSuccess) fprintf(stderr, "cooperative launch failed: %s (grid %d)\n", hipGetErrorString(e), grid_blocks);
}
```
